# Optimizing an MI355X kernel written in HIP

```python
import math
import jax, jax.numpy as jnp
from jax import lax
import numpy as np

D_MODEL = 2048
BATCH = 1
SEQ = 16384
DEPTH = 2

D_MIX = D_MODEL
S5_WIDTH = D_MIX // 4
S5_CH = 16
S5_GROUPS = S5_WIDTH // S5_CH
S5_STATE = 64
S5_DT_MIN = 0.001
S5_DT_MAX = 0.1
MLA_HEADS = 8
MLA_NOPE = 128
MLA_ROPE = 64
MLA_V = 128
MLA_Q_RANK = 512
MLA_KV_RANK = 256
MLA_WIDTH = MLA_HEADS * MLA_V
MLA_BLOCK = 128
ROPE_BASE = 10000.0
HG_WIDTH = D_MIX - S5_WIDTH - MLA_WIDTH
HG_HEAD_DIM = 128
HG_HEADS = HG_WIDTH // HG_HEAD_DIM
HG_CHUNK = 64
IN_COLS = S5_WIDTH + MLA_Q_RANK + MLA_KV_RANK + MLA_ROPE + 4 * HG_WIDTH
D_FF = 5632
N_EXPERTS = 8
TOP_K = 2
D_FF_EXPERT = 7168
N_DENSE = (DEPTH + 1) // 2
N_MOE = DEPTH // 2
DEEPNORM_ALPHA = (2 * DEPTH) ** 0.25
DEEPNORM_BETA = (8 * DEPTH) ** -0.25
LN_EPS = 1e-5
RMS_EPS = 1e-6

kernel_name = 'hybrid_s5_mla_hgrn2_deepnorm_moe'

F32 = jnp.float32


def layer_norm(x, g, b):
    xf = x.astype(F32)
    mu = jnp.mean(xf, axis=-1, keepdims=True)
    xc = xf - mu
    var = jnp.mean(xc * xc, axis=-1, keepdims=True)
    return (xc * lax.rsqrt(var + LN_EPS) * g.astype(F32) + b.astype(F32)).astype(x.dtype)


def rms_norm(x, g):
    xf = x.astype(F32)
    ms = jnp.mean(xf * xf, axis=-1, keepdims=True)
    return (xf * lax.rsqrt(ms + RMS_EPS) * g.astype(F32)).astype(x.dtype)


def rope(x, cos, sin):
    half = x.shape[-1] // 2
    x1, x2 = x[..., :half], x[..., half:]
    return jnp.concatenate([x1 * cos - x2 * sin, x1 * sin + x2 * cos], axis=-1).astype(x.dtype)


def s5_mixer(u, a_re, a_im, b_re, b_im, c_re, c_im, d, log_dt, w_glu, b_glu):
    bsz, seq, _ = u.shape
    uf = u.astype(F32).reshape(bsz, seq, S5_GROUPS, S5_CH)
    lam = lax.complex(jnp.minimum(a_re.astype(F32), -1e-4), a_im.astype(F32))
    dt = jnp.exp(log_dt.astype(F32))[:, None]
    lam_bar = jnp.exp(lam * dt)
    b = lax.complex(b_re.astype(F32), b_im.astype(F32))
    b_bar = ((lam_bar - 1.0) / lam)[..., None] * b
    bu = jnp.einsum('blgc,gpc->blgp', uf.astype(jnp.complex64), b_bar)
    a = jnp.broadcast_to(lam_bar, bu.shape)

    def combine(left, right):
        a_l, s_l = left
        a_r, s_r = right
        return a_r * a_l, a_r * s_l + s_r

    _, states = lax.associative_scan(combine, (a, bu), axis=1)
    c = lax.complex(c_re.astype(F32), c_im.astype(F32))
    y = jnp.real(jnp.einsum('gcp,blgp->blgc', c, states)) + d.astype(F32).reshape(S5_GROUPS, S5_CH) * uf
    y = jax.nn.gelu(y.reshape(bsz, seq, S5_WIDTH))
    y = y * jax.nn.sigmoid(y @ w_glu.astype(F32) + b_glu.astype(F32))
    return y.astype(u.dtype)


def mla_mixer(cq, ckv, kr, q_norm, w_uq, kv_norm, w_ukv, cos, sin):
    bsz, seq, _ = cq.shape
    q = jnp.einsum('blr,rhd->blhd', rms_norm(cq, q_norm), w_uq)
    q = jnp.concatenate([q[..., :MLA_NOPE], rope(q[..., MLA_NOPE:], cos[:, None], sin[:, None])], axis=-1)
    kv = jnp.einsum('blr,rhd->blhd', rms_norm(ckv, kv_norm), w_ukv)
    k_rope = rope(kr, cos, sin)
    k = jnp.concatenate([kv[..., :MLA_NOPE],
                         jnp.broadcast_to(k_rope[:, :, None, :], (bsz, seq, MLA_HEADS, MLA_ROPE))], axis=-1)
    v = kv[..., MLA_NOPE:]
    scale = (MLA_NOPE + MLA_ROPE) ** -0.5
    n_blocks = seq // MLA_BLOCK
    q_blocks = q.reshape(bsz, n_blocks, MLA_BLOCK, MLA_HEADS, MLA_NOPE + MLA_ROPE).transpose(1, 0, 2, 3, 4)
    key_pos = jnp.arange(seq)

    def attend(args):
        q_blk, blk = args
        s = jnp.einsum('bqhd,bkhd->bhqk', q_blk, k).astype(F32) * scale
        q_pos = blk * MLA_BLOCK + jnp.arange(MLA_BLOCK)
        s = jnp.where(key_pos[None, :] <= q_pos[:, None], s, -jnp.inf)
        p = jax.nn.softmax(s, axis=-1).astype(v.dtype)
        return jnp.einsum('bhqk,bkhd->bqhd', p, v)

    out = lax.map(attend, (q_blocks, jnp.arange(n_blocks)))
    return out.transpose(1, 0, 2, 3, 4).reshape(bsz, seq, MLA_WIDTH)


def hgrn2_mixer(q_raw, f_raw, i_raw, g_raw, lb, o_norm):
    bsz, seq, _ = q_raw.shape

    def heads(t):
        return t.astype(F32).reshape(bsz, seq, HG_HEADS, HG_HEAD_DIM)

    q = jax.nn.silu(heads(q_raw))
    z = heads(f_raw)
    lb_h = lb.astype(F32).reshape(HG_HEADS, HG_HEAD_DIM)
    log_f = jnp.logaddexp(jnp.log(lb_h), jnp.log1p(-lb_h) + jax.nn.log_sigmoid(z))
    k = (1.0 - lb_h) * jax.nn.sigmoid(-z)
    v = heads(i_raw)
    n_chunks = seq // HG_CHUNK

    def to_chunks(t):
        return t.reshape(bsz, n_chunks, HG_CHUNK, HG_HEADS, HG_HEAD_DIM).transpose(1, 0, 3, 2, 4)

    causal = jnp.tril(jnp.ones((HG_CHUNK, HG_CHUNK), dtype=bool))

    def step(state, chunk):
        q_c, k_c, v_c, lf_c = chunk
        b = jnp.cumsum(lf_c, axis=-2)
        o_inter = jnp.einsum('bhtd,bhde->bhte', q_c * jnp.exp(b), state)
        diff = jnp.where(causal[:, :, None], b[..., :, None, :] - b[..., None, :, :], -jnp.inf)
        attn = jnp.einsum('bhtd,bhsd,bhtsd->bhts', q_c, k_c, jnp.exp(diff))
        o = o_inter + jnp.einsum('bhts,bhse->bhte', attn, v_c)
        b_last = b[..., -1:, :]
        new_state = jnp.exp(b_last[..., 0, :])[..., None] * state + \
            jnp.einsum('bhsd,bhse->bhde', k_c * jnp.exp(b_last - b), v_c)
        return new_state, o

    state0 = jnp.zeros((bsz, HG_HEADS, HG_HEAD_DIM, HG_HEAD_DIM), F32)
    _, o = lax.scan(step, state0, (to_chunks(q), to_chunks(k), to_chunks(v), to_chunks(log_f)))
    o = o.transpose(1, 0, 3, 2, 4).reshape(bsz, seq, HG_HEADS, HG_HEAD_DIM)
    o = rms_norm(o, o_norm) * jax.nn.silu(heads(g_raw))
    return o.reshape(bsz, seq, HG_WIDTH).astype(q_raw.dtype)


def hybrid_mixer(x, w_in, w_out, s5_a_re, s5_a_im, s5_b_re, s5_b_im, s5_c_re, s5_c_im, s5_d,
                 s5_log_dt, s5_w_glu, s5_b_glu, mla_q_norm, mla_w_uq, mla_kv_norm, mla_w_ukv,
                 hg_lb, hg_o_norm, cos, sin):
    proj = x @ w_in
    sizes = (S5_WIDTH, MLA_Q_RANK, MLA_KV_RANK, MLA_ROPE) + (HG_WIDTH,) * 4
    offsets = np.cumsum(sizes)[:-1].tolist()
    u, cq, ckv, kr, hq, hf, hi, hg = jnp.split(proj, offsets, axis=-1)
    y_s5 = s5_mixer(u, s5_a_re, s5_a_im, s5_b_re, s5_b_im, s5_c_re, s5_c_im, s5_d, s5_log_dt, s5_w_glu, s5_b_glu)
    y_mla = mla_mixer(cq, ckv, kr, mla_q_norm, mla_w_uq, mla_kv_norm, mla_w_ukv, cos, sin)
    y_hg = hgrn2_mixer(hq, hf, hi, hg, hg_lb, hg_o_norm)
    y = jnp.concatenate([y_s5.astype(x.dtype), y_mla.astype(x.dtype), y_hg.astype(x.dtype)], axis=-1)
    return y @ w_out


def swiglu(x, w_gate, w_up, w_down):
    return (jax.nn.silu(x @ w_gate) * (x @ w_up)) @ w_down


def moe_ffn(x, w_router, w_gate, w_up, w_down):
    bsz, seq, d = x.shape
    xt = x.reshape(bsz * seq, d)
    logits = (xt @ w_router).astype(F32)
    top_vals, top_idx = lax.top_k(logits, TOP_K)
    top_w = jax.nn.softmax(top_vals, axis=-1)
    gates = jnp.sum(jax.nn.one_hot(top_idx, N_EXPERTS, dtype=F32) * top_w[..., None], axis=1)
    out = jnp.zeros((bsz * seq, d), F32)
    for e in range(N_EXPERTS):
        h = jax.nn.silu(xt @ w_gate[e]) * (xt @ w_up[e])
        out = out + gates[:, e:e + 1] * (h @ w_down[e]).astype(F32)
    return out.reshape(bsz, seq, d).astype(x.dtype)


def setup_inputs(seed: int = 0) -> dict:
    key = jax.random.key(seed)
    ks = iter(jax.random.split(key, 40))

    def nrm(shape, scale):
        return jax.random.normal(next(ks), shape, F32) * scale

    L = DEPTH
    G, P, C = S5_GROUPS, S5_STATE, S5_CH
    x = nrm((BATCH, SEQ, D_MODEL), 1.0)
    w_in = nrm((L, D_MODEL, IN_COLS), D_MODEL ** -0.5)
    w_out = nrm((L, D_MIX, D_MODEL), D_MIX ** -0.5 * DEEPNORM_BETA)
    s5_a_re = -0.5 + nrm((L, G, P), 0.01)
    s5_a_im = math.pi * jnp.arange(P, dtype=F32)[None, None, :] + nrm((L, G, P), 0.01)
    s5_b_re = nrm((L, G, P, C), (2 * C) ** -0.5)
    s5_b_im = nrm((L, G, P, C), (2 * C) ** -0.5)
    s5_c_re = nrm((L, G, C, P), P ** -0.5)
    s5_c_im = nrm((L, G, C, P), P ** -0.5)
    s5_d = nrm((L, S5_WIDTH), 1.0)
    s5_log_dt = jax.random.uniform(next(ks), (L, G), F32, math.log(S5_DT_MIN), math.log(S5_DT_MAX))
    s5_w_glu = nrm((L, S5_WIDTH, S5_WIDTH), S5_WIDTH ** -0.5)
    s5_b_glu = nrm((L, S5_WIDTH), 0.01)
    mla_q_norm = 1.0 + nrm((L, MLA_Q_RANK), 0.01)
    mla_w_uq = nrm((L, MLA_Q_RANK, MLA_HEADS, MLA_NOPE + MLA_ROPE), MLA_Q_RANK ** -0.5)
    mla_kv_norm = 1.0 + nrm((L, MLA_KV_RANK), 0.01)
    mla_w_ukv = nrm((L, MLA_KV_RANK, MLA_HEADS, MLA_NOPE + MLA_V), MLA_KV_RANK ** -0.5)
    hg_lb_logits = nrm((L, HG_WIDTH), 1.0)
    hg_o_norm = 1.0 + nrm((L, HG_HEAD_DIM), 0.01)
    ln1_g = 1.0 + nrm((L, D_MODEL), 0.01)
    ln1_b = nrm((L, D_MODEL), 0.01)
    ln2_g = 1.0 + nrm((L, D_MODEL), 0.01)
    ln2_b = nrm((L, D_MODEL), 0.01)
    ffn_w_gate = nrm((N_DENSE, D_MODEL, D_FF), D_MODEL ** -0.5)
    ffn_w_up = nrm((N_DENSE, D_MODEL, D_FF), D_MODEL ** -0.5)
    ffn_w_down = nrm((N_DENSE, D_FF, D_MODEL), D_FF ** -0.5 * DEEPNORM_BETA)
    moe_router = nrm((N_MOE, D_MODEL, N_EXPERTS), D_MODEL ** -0.5)
    moe_w_gate = nrm((N_MOE, N_EXPERTS, D_MODEL, D_FF_EXPERT), D_MODEL ** -0.5)
    moe_w_up = nrm((N_MOE, N_EXPERTS, D_MODEL, D_FF_EXPERT), D_MODEL ** -0.5)
    moe_w_down = nrm((N_MOE, N_EXPERTS, D_FF_EXPERT, D_MODEL), D_FF_EXPERT ** -0.5 * DEEPNORM_BETA)
    return {'x': x, 'w_in': w_in, 'w_out': w_out,
            's5_a_re': s5_a_re, 's5_a_im': s5_a_im, 's5_b_re': s5_b_re, 's5_b_im': s5_b_im,
            's5_c_re': s5_c_re, 's5_c_im': s5_c_im, 's5_d': s5_d, 's5_log_dt': s5_log_dt,
            's5_w_glu': s5_w_glu, 's5_b_glu': s5_b_glu,
            'mla_q_norm': mla_q_norm, 'mla_w_uq': mla_w_uq, 'mla_kv_norm': mla_kv_norm, 'mla_w_ukv': mla_w_ukv,
            'hg_lb_logits': hg_lb_logits, 'hg_o_norm': hg_o_norm,
            'ln1_g': ln1_g, 'ln1_b': ln1_b, 'ln2_g': ln2_g, 'ln2_b': ln2_b,
            'ffn_w_gate': ffn_w_gate, 'ffn_w_up': ffn_w_up, 'ffn_w_down': ffn_w_down,
            'moe_router': moe_router, 'moe_w_gate': moe_w_gate, 'moe_w_up': moe_w_up, 'moe_w_down': moe_w_down}


def reference(x, w_in, w_out, s5_a_re, s5_a_im, s5_b_re, s5_b_im, s5_c_re, s5_c_im, s5_d, s5_log_dt,
              s5_w_glu, s5_b_glu, mla_q_norm, mla_w_uq, mla_kv_norm, mla_w_ukv, hg_lb_logits, hg_o_norm,
              ln1_g, ln1_b, ln2_g, ln2_b, ffn_w_gate, ffn_w_up, ffn_w_down,
              moe_router, moe_w_gate, moe_w_up, moe_w_down):
    seq = x.shape[1]
    pos = jnp.arange(seq, dtype=F32)
    inv_freq = ROPE_BASE ** (-jnp.arange(0, MLA_ROPE, 2, dtype=F32) / MLA_ROPE)
    ang = pos[:, None] * inv_freq[None, :]
    cos, sin = jnp.cos(ang), jnp.sin(ang)
    lb_all = jnp.cumsum(jax.nn.softmax(hg_lb_logits.astype(F32), axis=0), axis=0)
    lb_all = lb_all - lb_all[:1]
    for layer in range(DEPTH):
        h = hybrid_mixer(x, w_in[layer], w_out[layer], s5_a_re[layer], s5_a_im[layer], s5_b_re[layer],
                         s5_b_im[layer], s5_c_re[layer], s5_c_im[layer], s5_d[layer], s5_log_dt[layer],
                         s5_w_glu[layer], s5_b_glu[layer], mla_q_norm[layer], mla_w_uq[layer],
                         mla_kv_norm[layer], mla_w_ukv[layer], lb_all[layer], hg_o_norm[layer], cos, sin)
        x = layer_norm(DEEPNORM_ALPHA * x + h, ln1_g[layer], ln1_b[layer])
        j = layer // 2
        if layer % 2 == 0:
            f = swiglu(x, ffn_w_gate[j], ffn_w_up[j], ffn_w_down[j])
        else:
            f = moe_ffn(x, moe_router[j], moe_w_gate[j], moe_w_up[j], moe_w_down[j])
        x = layer_norm(DEEPNORM_ALPHA * x + f, ln2_g[layer], ln2_b[layer])
    return x
```

```cpp
#include <hip/hip_runtime.h>
#include <cstdio>
#include <cstdint>
#include <cmath>
namespace pg8 {
#define PG8_LAS __attribute__((address_space(3)))
typedef unsigned short bf16_t;
typedef short bf16x8 __attribute__((ext_vector_type(8)));
typedef float f32x4 __attribute__((ext_vector_type(4)));
typedef unsigned u32x4 __attribute__((ext_vector_type(4)));
constexpr int BM = 256, BK = 64, HALF = 128, HTB = HALF * BK * 2  , STAGE_BYTES = 8 * HTB, NXCD = 8, WGM = 8;

__host__ __device__ __forceinline__ int lds_byte(int r, int c) { const int st = (r >> 4) * 2 + (c >> 5), rr = r & 15, cc = c & 31, ob = rr * 64 + cc * 2; return st * 1024 + (ob ^ (((ob >> 9) & 1) << 5)); }
__host__ __device__ __forceinline__ void stage_rc(int b, int& R, int& C) { const int st = b / 1024, sb = b % 1024, swz = sb ^ (((sb >> 9) & 1) << 5); R = (st >> 1) * 16 + swz / 64; C = (st & 1) * 32 + (swz % 64) / 2; }
__host__ __device__ __forceinline__ int perm32(int rho) { const int n = rho >> 4, i = rho & 15; return 8 * (i >> 2) + 4 * n + (i & 3); }

struct Unit { int pm, pn, pa, pb; };
struct Gemm { const bf16_t* A; const bf16_t* Bt; int M, N, K, lda, ldb; };

struct StaticOrder {
    int nM, nN, nwg, G, c;
    __host__ __device__ void init(int M, int N, int G_, int c_) { nM = M / BM; nN = N / BM; nwg = nM * nN; G = G_; c = c_; }
    __host__ __device__ bool next(int i, Unit& u) const {
        const long L = (long)i * G + c; if (L >= nwg) return false;
        int wgid = (int)L; { const int q = nwg / NXCD, r = nwg % NXCD, xcd = wgid % NXCD, off = wgid / NXCD; wgid = (xcd < r ? xcd * (q + 1) : r * (q + 1) + (xcd - r) * q) + off; }
        const int nig = WGM * nN, gid = wgid / nig, fm = gid * WGM, gsz = (nM - fm) < WGM ? (nM - fm) : WGM;
        u.pm = fm + ((wgid % nig) % gsz); u.pn = (wgid % nig) / gsz; u.pa = u.pm; u.pb = u.pn; return true;
    }
    __device__ __forceinline__ void a_ready(const Unit&) const {}
    __device__ __forceinline__ void done(const Unit&) const {}
};


__device__ __forceinline__ unsigned cvt_pk_bf16(float lo, float hi) { unsigned r; asm volatile("v_cvt_pk_bf16_f32 %0, %1, %2" : "=v"(r) : "v"(lo), "v"(hi)); return r; }
typedef float f32x2 __attribute__((ext_vector_type(2)));
template <class Epi, class Sched, bool ALIGN_EPI = false, bool SP2 = false>
__device__ __forceinline__ void gemm_phase(PG8_LAS unsigned char* lds, const Gemm g, const Sched& S, const Epi& E) {
    int tid_ = threadIdx.x; asm volatile("" : "+v"(tid_));
    const int tid = tid_, wid = __builtin_amdgcn_readfirstlane(tid >> 6), lane = tid & 63, wr = wid >> 2, wc = wid & 3, fr = lane & 15, fq = lane >> 4;
    const int K = g.K, nt = K / BK;
    unsigned voffA, voffB;
    { int R, C; stage_rc(tid * 16, R, C); const int Rb = Epi::PERM ? ((R & ~31) + perm32(R & 31)) : R;
        voffA = (unsigned)(R * g.lda + C) * 2u; voffB = (unsigned)(Rb * K + C) * 2u; }
    const size_t rsA = (size_t)64 * g.lda * 2, rsB = (size_t)64 * K * 2;
    const size_t kstep = (size_t)(BK * 2);
    const size_t hstepA = (size_t)HALF * g.lda * 2, hstepB = (size_t)HALF * K * 2;
    const size_t tstepA = 2 * hstepA, tstepB = 2 * hstepB;
    const unsigned ldsw = (unsigned)wid * 1024u;
    const int aoff = lds_byte(wr * 64 + fr, fq * 8), boff = lds_byte(wc * 32 + fr, fq * 8);
#define PG8_SA(b, h) (((b) * 2 + (h)) * HTB)
#define PG8_SB(b, h) ((4 + (b) * 2 + (h)) * HTB)
#define PG8_STAGE(bufoff, gbase, voff) do { _Pragma("unroll") for (int _i = 0; _i < 2; ++_i) \
        __builtin_amdgcn_global_load_lds((const unsigned*)((const char*)(gbase) + (size_t)_i * PG8_RS_##voff + (voff)), (PG8_LAS unsigned*)(lds + (bufoff) + ldsw + _i * 8192), 16, 0, 0); } while (0)
#define PG8_RS_voffA rsA
#define PG8_RS_voffB rsB
#define PG8_LDA(dst, b, h) do { _Pragma("unroll") for (int m = 0; m < 4; ++m) _Pragma("unroll") for (int k = 0; k < 2; ++k) dst[m][k] = *(const PG8_LAS bf16x8*)(lds + PG8_SA(b, h) + aoff + m * 2048 + k * 1024); } while (0)
#define PG8_LDB(dst, b, h) do { _Pragma("unroll") for (int n = 0; n < 2; ++n) _Pragma("unroll") for (int k = 0; k < 2; ++k) dst[n][k] = *(const PG8_LAS bf16x8*)(lds + PG8_SB(b, h) + boff + n * 2048 + k * 1024); } while (0)
#define PG8_MMA(ai, bj, At, Bt) do { __builtin_amdgcn_s_setprio(1); _Pragma("unroll") for (int m = 0; m < 4; ++m) _Pragma("unroll") for (int n = 0; n < 2; ++n) _Pragma("unroll") for (int k = 0; k < 2; ++k) \
        acc[ai][bj][m][n] = __builtin_amdgcn_mfma_f32_16x16x32_bf16(Bt[n][k], At[m][k], acc[ai][bj][m][n], 0, 0, 0); __builtin_amdgcn_s_setprio(0); } while (0)
#define PG8_WAIT_V(n) asm volatile("s_waitcnt vmcnt(" #n ")" ::: "memory")
#define PG8_WAIT_L(n) asm volatile("s_waitcnt lgkmcnt(" #n ")" ::: "memory")
#define PG8_BAR __builtin_amdgcn_s_barrier()
#define PG8_SCHED __builtin_amdgcn_sched_barrier(0)
    Unit cur, nxt; int ui = 0;
    if (!S.next(0, cur)) return;
    f32x4 acc[2][2][4][2];
#pragma unroll
    for (int a = 0; a < 2; ++a)
#pragma unroll
        for (int b = 0; b < 2; ++b)
#pragma unroll
            for (int m = 0; m < 4; ++m)
#pragma unroll
                for (int n = 0; n < 2; ++n) acc[a][b][m][n] = (f32x4){0.f, 0.f, 0.f, 0.f};
    bf16x8 At[4][2], B0[2][2], B1[2][2];
    const char* cA = (const char*)g.A + (size_t)cur.pa * tstepA; const char* cB = (const char*)g.Bt + (size_t)cur.pb * tstepB;
    S.a_ready(cur);
    if constexpr (SP2) {
        PG8_STAGE(PG8_SB(0, 0), cB, voffB); PG8_STAGE(PG8_SB(0, 1), cB + hstepB, voffB); PG8_STAGE(PG8_SA(0, 0), cA, voffA); PG8_STAGE(PG8_SA(0, 1), cA + hstepA, voffA);
        if (wr == 1) PG8_BAR;
        PG8_WAIT_V(2); PG8_BAR;
        PG8_STAGE(PG8_SB(1, 0), cB + kstep, voffB); PG8_STAGE(PG8_SA(1, 0), cA + kstep, voffA); PG8_STAGE(PG8_SB(1, 1), cB + hstepB + kstep, voffB);
        PG8_WAIT_V(6); PG8_BAR;
    } else {
        PG8_STAGE(PG8_SB(0, 0), cB, voffB); PG8_STAGE(PG8_SA(0, 0), cA, voffA); PG8_STAGE(PG8_SB(0, 1), cB + hstepB, voffB); PG8_STAGE(PG8_SA(0, 1), cA + hstepA, voffA);
        if (wr == 1) PG8_BAR;
        PG8_WAIT_V(4); PG8_BAR;
        PG8_STAGE(PG8_SB(1, 0), cB + kstep, voffB); PG8_STAGE(PG8_SA(1, 0), cA + kstep, voffA); PG8_STAGE(PG8_SB(1, 1), cB + hstepB + kstep, voffB);
        PG8_WAIT_V(6); PG8_BAR;
    }
    for (;;) {
        const bool has_next = S.next(ui + 1, nxt);
        const char* nA = has_next ? (const char*)g.A + (size_t)nxt.pa * tstepA : cA; const char* nB = has_next ? (const char*)g.Bt + (size_t)nxt.pb * tstepB : cB;
        for (int t = 0; t < nt; t += 2) {
            const bool last = (t == nt - 2);
            const char* a1 = cA + (size_t)(t + 1) * kstep;
            const char* a2 = last ? nA : cA + (size_t)(t + 2) * kstep; const char* b2 = last ? nB : cB + (size_t)(t + 2) * kstep;
            const char* a3 = a2 + kstep; const char* b3 = b2 + kstep;
            if (last && has_next) S.a_ready(nxt);
            if constexpr (SP2) {
            PG8_LDB(B0, 0, 0); PG8_LDB(B1, 0, 1); PG8_SCHED; PG8_LDA(At, 0, 0); PG8_STAGE(PG8_SA(1, 1), a1 + hstepA, voffA);
            PG8_WAIT_V(8); PG8_WAIT_L(0); PG8_BAR; PG8_MMA(0, 0, At, B0); PG8_MMA(0, 1, At, B1); PG8_BAR; PG8_SCHED;
            PG8_LDA(At, 0, 1); PG8_STAGE(PG8_SB(0, 0), b2, voffB); PG8_STAGE(PG8_SB(0, 1), b2 + hstepB, voffB); PG8_STAGE(PG8_SA(0, 0), a2, voffA);
            PG8_WAIT_V(8); PG8_WAIT_L(0); PG8_BAR; PG8_MMA(1, 0, At, B0); PG8_MMA(1, 1, At, B1); PG8_BAR; PG8_SCHED;
            PG8_LDB(B0, 1, 0); PG8_LDB(B1, 1, 1); PG8_SCHED; PG8_LDA(At, 1, 0); PG8_STAGE(PG8_SA(0, 1), a2 + hstepA, voffA);
            PG8_WAIT_V(8); PG8_WAIT_L(0); PG8_BAR; PG8_MMA(0, 0, At, B0); PG8_MMA(0, 1, At, B1); PG8_BAR; PG8_SCHED;
            PG8_LDA(At, 1, 1); PG8_STAGE(PG8_SB(1, 0), b3, voffB); PG8_STAGE(PG8_SB(1, 1), b3 + hstepB, voffB); PG8_STAGE(PG8_SA(1, 0), a3, voffA);
            PG8_WAIT_V(8); PG8_WAIT_L(0); PG8_BAR; PG8_MMA(1, 0, At, B0); PG8_MMA(1, 1, At, B1); PG8_BAR; PG8_SCHED;
            } else {
            PG8_LDB(B0, 0, 0); PG8_SCHED; PG8_LDA(At, 0, 0); PG8_STAGE(PG8_SA(1, 1), a1 + hstepA, voffA);
            PG8_WAIT_L(8); PG8_BAR; PG8_WAIT_L(0); PG8_MMA(0, 0, At, B0); PG8_BAR; PG8_SCHED;
            PG8_LDB(B1, 0, 1); PG8_STAGE(PG8_SB(0, 0), b2, voffB);
            PG8_BAR; PG8_WAIT_L(0); PG8_MMA(0, 1, At, B1); PG8_BAR;
            PG8_LDA(At, 0, 1); PG8_STAGE(PG8_SA(0, 0), a2, voffA);
            PG8_BAR; PG8_WAIT_L(0); PG8_MMA(1, 0, At, B0); PG8_BAR; PG8_SCHED;
            PG8_STAGE(PG8_SB(0, 1), b2 + hstepB, voffB);
            PG8_WAIT_V(6); PG8_BAR; PG8_MMA(1, 1, At, B1); PG8_BAR;
            PG8_LDB(B0, 1, 0); PG8_SCHED; PG8_LDA(At, 1, 0); PG8_STAGE(PG8_SA(0, 1), a2 + hstepA, voffA);
            PG8_WAIT_L(8); PG8_BAR; PG8_WAIT_L(0); PG8_MMA(0, 0, At, B0); PG8_BAR; PG8_SCHED;
            PG8_LDB(B1, 1, 1); PG8_STAGE(PG8_SB(1, 0), b3, voffB);
            PG8_BAR; PG8_WAIT_L(0); PG8_MMA(0, 1, At, B1); PG8_BAR;
            PG8_LDA(At, 1, 1); PG8_STAGE(PG8_SA(1, 0), a3, voffA);
            PG8_BAR; PG8_WAIT_L(0); PG8_MMA(1, 0, At, B0); PG8_BAR; PG8_SCHED;
            PG8_STAGE(PG8_SB(1, 1), b3 + hstepB, voffB);
            PG8_WAIT_V(6); PG8_BAR; PG8_MMA(1, 1, At, B1); PG8_BAR;
            }
        }
        if constexpr (ALIGN_EPI) { if (wr == 0) PG8_BAR; }
        if constexpr (!Epi::AFTER_DRAIN) { E(acc, cur, wr, wc, fr, fq); S.done(cur); }
        if (!has_next) break;
#pragma unroll
        for (int a = 0; a < 2; ++a)
#pragma unroll
            for (int b = 0; b < 2; ++b)
#pragma unroll
                for (int m = 0; m < 4; ++m)
#pragma unroll
                    for (int n = 0; n < 2; ++n) acc[a][b][m][n] = (f32x4){0.f, 0.f, 0.f, 0.f};
        cur = nxt; cA = nA; cB = nB; ++ui;
        if constexpr (ALIGN_EPI) { if (wr == 1) PG8_BAR; }
    }
    PG8_WAIT_V(0);
    if constexpr (!ALIGN_EPI) { if (wr == 0) PG8_BAR; }
    PG8_BAR;
    if constexpr (Epi::AFTER_DRAIN) { E.fused(acc, cur, wr, wc, fr, fq, lds, wid, lane); S.done(cur); }
#undef PG8_SA
#undef PG8_SB
#undef PG8_STAGE
#undef PG8_RS_voffA
#undef PG8_RS_voffB
#undef PG8_LDA
#undef PG8_LDB
#undef PG8_MMA
#undef PG8_WAIT_V
#undef PG8_WAIT_L
#undef PG8_BAR
#undef PG8_SCHED
}
typedef int i32x4 __attribute__((ext_vector_type(4)));
template <class Epi, class Sched, bool ALIGN_EPI = false, bool SP2 = false>
__device__ __forceinline__ void gemm_phase_i8(PG8_LAS unsigned char* lds, const Gemm g, const Sched& S, const Epi& E) {
    int tid_ = threadIdx.x; asm volatile("" : "+v"(tid_));
    const int tid = tid_, wid = __builtin_amdgcn_readfirstlane(tid >> 6), lane = tid & 63, wr = wid >> 2, wc = wid & 3, fr = lane & 15, fq = lane >> 4;
    const int K = g.K, nt = K / BK;
    unsigned voffA, voffB;
    { int R, C; stage_rc(tid * 16, R, C); const int Rb = Epi::PERM ? ((R & ~31) + perm32(R & 31)) : R;
        voffA = (unsigned)(R * g.lda + C) * 2u; voffB = (unsigned)(Rb * K + C) * 2u; }
    const size_t rsA = (size_t)64 * g.lda * 2, rsB = (size_t)64 * K * 2;
    const size_t kstep = (size_t)(BK * 2);
    const size_t hstepA = (size_t)HALF * g.lda * 2, hstepB = (size_t)HALF * K * 2;
    const size_t tstepA = 2 * hstepA, tstepB = 2 * hstepB;
    const unsigned ldsw = (unsigned)wid * 1024u;
    const int aoff = lds_byte(wr * 64 + fr, fq * 8), boff = lds_byte(wc * 32 + fr, fq * 8);
#define PG8_SA(b, h) (((b) * 2 + (h)) * HTB)
#define PG8_SB(b, h) ((4 + (b) * 2 + (h)) * HTB)
#define PG8_STAGE(bufoff, gbase, voff) do { _Pragma("unroll") for (int _i = 0; _i < 2; ++_i) \
        __builtin_amdgcn_global_load_lds((const unsigned*)((const char*)(gbase) + (size_t)_i * PG8_RS_##voff + (voff)), (PG8_LAS unsigned*)(lds + (bufoff) + ldsw + _i * 8192), 16, 0, 0); } while (0)
#define PG8_RS_voffA rsA
#define PG8_RS_voffB rsB
#define PG8_LDA(dst, b, h) do { _Pragma("unroll") for (int m = 0; m < 4; ++m) _Pragma("unroll") for (int k = 0; k < 2; ++k) dst[m][k] = *(const PG8_LAS bf16x8*)(lds + PG8_SA(b, h) + aoff + m * 2048 + k * 1024); } while (0)
#define PG8_LDB(dst, b, h) do { _Pragma("unroll") for (int n = 0; n < 2; ++n) _Pragma("unroll") for (int k = 0; k < 2; ++k) dst[n][k] = *(const PG8_LAS bf16x8*)(lds + PG8_SB(b, h) + boff + n * 2048 + k * 1024); } while (0)
#define PG8_MMA(ai, bj, At, Bt) do { __builtin_amdgcn_s_setprio(1); _Pragma("unroll") for (int m = 0; m < 4; ++m) _Pragma("unroll") for (int n = 0; n < 2; ++n) _Pragma("unroll") for (int k = 0; k < 2; ++k) \
        acc[ai][bj][m][n] = __builtin_amdgcn_mfma_i32_16x16x64_i8(__builtin_bit_cast(i32x4, Bt[n][k]), __builtin_bit_cast(i32x4, At[m][k]), acc[ai][bj][m][n], 0, 0, 0); __builtin_amdgcn_s_setprio(0); } while (0)
#define PG8_WAIT_V(n) asm volatile("s_waitcnt vmcnt(" #n ")" ::: "memory")
#define PG8_WAIT_L(n) asm volatile("s_waitcnt lgkmcnt(" #n ")" ::: "memory")
#define PG8_BAR __builtin_amdgcn_s_barrier()
#define PG8_SCHED __builtin_amdgcn_sched_barrier(0)
    Unit cur, nxt; int ui = 0;
    if (!S.next(0, cur)) return;
    i32x4 acc[2][2][4][2];
#pragma unroll
    for (int a = 0; a < 2; ++a)
#pragma unroll
        for (int b = 0; b < 2; ++b)
#pragma unroll
            for (int m = 0; m < 4; ++m)
#pragma unroll
                for (int n = 0; n < 2; ++n) acc[a][b][m][n] = (i32x4){0, 0, 0, 0};
    bf16x8 At[4][2], B0[2][2], B1[2][2];
    const char* cA = (const char*)g.A + (size_t)cur.pa * tstepA; const char* cB = (const char*)g.Bt + (size_t)cur.pb * tstepB;
    S.a_ready(cur);
    if constexpr (SP2) {
        PG8_STAGE(PG8_SB(0, 0), cB, voffB); PG8_STAGE(PG8_SB(0, 1), cB + hstepB, voffB); PG8_STAGE(PG8_SA(0, 0), cA, voffA); PG8_STAGE(PG8_SA(0, 1), cA + hstepA, voffA);
        if (wr == 1) PG8_BAR;
        PG8_WAIT_V(2); PG8_BAR;
        PG8_STAGE(PG8_SB(1, 0), cB + kstep, voffB); PG8_STAGE(PG8_SA(1, 0), cA + kstep, voffA); PG8_STAGE(PG8_SB(1, 1), cB + hstepB + kstep, voffB);
        PG8_WAIT_V(6); PG8_BAR;
    } else {
        PG8_STAGE(PG8_SB(0, 0), cB, voffB); PG8_STAGE(PG8_SA(0, 0), cA, voffA); PG8_STAGE(PG8_SB(0, 1), cB + hstepB, voffB); PG8_STAGE(PG8_SA(0, 1), cA + hstepA, voffA);
        if (wr == 1) PG8_BAR;
        PG8_WAIT_V(4); PG8_BAR;
        PG8_STAGE(PG8_SB(1, 0), cB + kstep, voffB); PG8_STAGE(PG8_SA(1, 0), cA + kstep, voffA); PG8_STAGE(PG8_SB(1, 1), cB + hstepB + kstep, voffB);
        PG8_WAIT_V(6); PG8_BAR;
    }
    for (;;) {
        const bool has_next = S.next(ui + 1, nxt);
        const char* nA = has_next ? (const char*)g.A + (size_t)nxt.pa * tstepA : cA; const char* nB = has_next ? (const char*)g.Bt + (size_t)nxt.pb * tstepB : cB;
        for (int t = 0; t < nt; t += 2) {
            const bool last = (t == nt - 2);
            const char* a1 = cA + (size_t)(t + 1) * kstep;
            const char* a2 = last ? nA : cA + (size_t)(t + 2) * kstep; const char* b2 = last ? nB : cB + (size_t)(t + 2) * kstep;
            const char* a3 = a2 + kstep; const char* b3 = b2 + kstep;
            if (last && has_next) S.a_ready(nxt);
            if constexpr (SP2) {
            PG8_LDB(B0, 0, 0); PG8_LDB(B1, 0, 1); PG8_SCHED; PG8_LDA(At, 0, 0); PG8_STAGE(PG8_SA(1, 1), a1 + hstepA, voffA);
            PG8_WAIT_V(8); PG8_WAIT_L(0); PG8_BAR; PG8_MMA(0, 0, At, B0); PG8_MMA(0, 1, At, B1); PG8_BAR; PG8_SCHED;
            PG8_LDA(At, 0, 1); PG8_STAGE(PG8_SB(0, 0), b2, voffB); PG8_STAGE(PG8_SB(0, 1), b2 + hstepB, voffB); PG8_STAGE(PG8_SA(0, 0), a2, voffA);
            PG8_WAIT_V(8); PG8_WAIT_L(0); PG8_BAR; PG8_MMA(1, 0, At, B0); PG8_MMA(1, 1, At, B1); PG8_BAR; PG8_SCHED;
            PG8_LDB(B0, 1, 0); PG8_LDB(B1, 1, 1); PG8_SCHED; PG8_LDA(At, 1, 0); PG8_STAGE(PG8_SA(0, 1), a2 + hstepA, voffA);
            PG8_WAIT_V(8); PG8_WAIT_L(0); PG8_BAR; PG8_MMA(0, 0, At, B0); PG8_MMA(0, 1, At, B1); PG8_BAR; PG8_SCHED;
            PG8_LDA(At, 1, 1); PG8_STAGE(PG8_SB(1, 0), b3, voffB); PG8_STAGE(PG8_SB(1, 1), b3 + hstepB, voffB); PG8_STAGE(PG8_SA(1, 0), a3, voffA);
            PG8_WAIT_V(8); PG8_WAIT_L(0); PG8_BAR; PG8_MMA(1, 0, At, B0); PG8_MMA(1, 1, At, B1); PG8_BAR; PG8_SCHED;
            } else {
            PG8_LDB(B0, 0, 0); PG8_SCHED; PG8_LDA(At, 0, 0); PG8_STAGE(PG8_SA(1, 1), a1 + hstepA, voffA);
            PG8_WAIT_L(8); PG8_BAR; PG8_WAIT_L(0); PG8_MMA(0, 0, At, B0); PG8_BAR; PG8_SCHED;
            PG8_LDB(B1, 0, 1); PG8_STAGE(PG8_SB(0, 0), b2, voffB);
            PG8_BAR; PG8_WAIT_L(0); PG8_MMA(0, 1, At, B1); PG8_BAR;
            PG8_LDA(At, 0, 1); PG8_STAGE(PG8_SA(0, 0), a2, voffA);
            PG8_BAR; PG8_WAIT_L(0); PG8_MMA(1, 0, At, B0); PG8_BAR; PG8_SCHED;
            PG8_STAGE(PG8_SB(0, 1), b2 + hstepB, voffB);
            PG8_WAIT_V(6); PG8_BAR; PG8_MMA(1, 1, At, B1); PG8_BAR;
            PG8_LDB(B0, 1, 0); PG8_SCHED; PG8_LDA(At, 1, 0); PG8_STAGE(PG8_SA(0, 1), a2 + hstepA, voffA);
            PG8_WAIT_L(8); PG8_BAR; PG8_WAIT_L(0); PG8_MMA(0, 0, At, B0); PG8_BAR; PG8_SCHED;
            PG8_LDB(B1, 1, 1); PG8_STAGE(PG8_SB(1, 0), b3, voffB);
            PG8_BAR; PG8_WAIT_L(0); PG8_MMA(0, 1, At, B1); PG8_BAR;
            PG8_LDA(At, 1, 1); PG8_STAGE(PG8_SA(1, 0), a3, voffA);
            PG8_BAR; PG8_WAIT_L(0); PG8_MMA(1, 0, At, B0); PG8_BAR; PG8_SCHED;
            PG8_STAGE(PG8_SB(1, 1), b3 + hstepB, voffB);
            PG8_WAIT_V(6); PG8_BAR; PG8_MMA(1, 1, At, B1); PG8_BAR;
            }
        }
        if constexpr (ALIGN_EPI) { if (wr == 0) PG8_BAR; }
        if constexpr (!Epi::AFTER_DRAIN) { f32x4 accf[2][2][4][2];
#pragma unroll
            for (int a = 0; a < 2; ++a)
#pragma unroll
                for (int b = 0; b < 2; ++b)
#pragma unroll
                    for (int m = 0; m < 4; ++m)
#pragma unroll
                        for (int n = 0; n < 2; ++n) accf[a][b][m][n] = __builtin_convertvector(acc[a][b][m][n], f32x4);
            E(accf, cur, wr, wc, fr, fq); S.done(cur); }
        if (!has_next) break;
#pragma unroll
        for (int a = 0; a < 2; ++a)
#pragma unroll
            for (int b = 0; b < 2; ++b)
#pragma unroll
                for (int m = 0; m < 4; ++m)
#pragma unroll
                    for (int n = 0; n < 2; ++n) acc[a][b][m][n] = (i32x4){0, 0, 0, 0};
        cur = nxt; cA = nA; cB = nB; ++ui;
        if constexpr (ALIGN_EPI) { if (wr == 1) PG8_BAR; }
    }
    PG8_WAIT_V(0);
    if constexpr (!ALIGN_EPI) { if (wr == 0) PG8_BAR; }
    PG8_BAR;
#undef PG8_SA
#undef PG8_SB
#undef PG8_STAGE
#undef PG8_RS_voffA
#undef PG8_RS_voffB
#undef PG8_LDA
#undef PG8_LDB
#undef PG8_MMA
#undef PG8_WAIT_V
#undef PG8_WAIT_L
#undef PG8_BAR
#undef PG8_SCHED
}
typedef int v8i __attribute__((ext_vector_type(8)));
typedef short s16x16 __attribute__((ext_vector_type(16)));
template <class Epi, class Sched, bool ALIGN_EPI = false, bool SP2 = false>
__device__ __forceinline__ void gemm_phase8(PG8_LAS unsigned char* lds, const Gemm g, const Sched& S, const Epi& E) {
    int tid_ = threadIdx.x; asm volatile("" : "+v"(tid_));
    const int tid = tid_, wid = __builtin_amdgcn_readfirstlane(tid >> 6), lane = tid & 63, wr = wid >> 2, wc = wid & 3, fr = lane & 15, fq = lane >> 4;
    const int K = g.K, nt = K / BK;
    int scl_ = 0x7f7f7f7f; asm volatile("" : "+v"(scl_));
    unsigned voffA, voffB;
    { int R, C; stage_rc(tid * 16, R, C); const int Rb = Epi::PERM ? ((R & ~31) + perm32(R & 31)) : R;
        voffA = (unsigned)(R * g.lda + C) * 2u; voffB = (unsigned)(Rb * (g.ldb ? g.ldb : K) + C) * 2u; }
    const int ldb = g.ldb ? g.ldb : K;
    const size_t rsA = (size_t)64 * g.lda * 2, rsB = (size_t)64 * ldb * 2;
    const size_t kstep = (size_t)(BK * 2);
    const size_t hstepA = (size_t)HALF * g.lda * 2, hstepB = (size_t)HALF * ldb * 2;
    const size_t tstepA = 2 * hstepA, tstepB = 2 * hstepB;
    const unsigned ldsw = (unsigned)wid * 1024u;
    const int aoff = lds_byte(wr * 64 + fr, fq * 16), boff = lds_byte(wc * 32 + fr, fq * 16);
#define PG8_SA(b, h) (((b) * 2 + (h)) * HTB)
#define PG8_SB(b, h) ((4 + (b) * 2 + (h)) * HTB)
#define PG8_STAGE(bufoff, gbase, voff) do { _Pragma("unroll") for (int _i = 0; _i < 2; ++_i) \
        __builtin_amdgcn_global_load_lds((const unsigned*)((const char*)(gbase) + (size_t)_i * PG8_RS_##voff + (voff)), (PG8_LAS unsigned*)(lds + (bufoff) + ldsw + _i * 8192), 16, 0, 0); } while (0)
#define PG8_RS_voffA rsA
#define PG8_RS_voffB rsB
#define PG8_LDA(dst, b, h) do { _Pragma("unroll") for (int m = 0; m < 4; ++m) { const bf16x8 lo_ = *(const PG8_LAS bf16x8*)(lds + PG8_SA(b, h) + aoff + m * 2048), hi_ = *(const PG8_LAS bf16x8*)(lds + PG8_SA(b, h) + aoff + m * 2048 + 16); dst[m] = __builtin_bit_cast(v8i, __builtin_shufflevector(lo_, hi_, 0, 1, 2, 3, 4, 5, 6, 7, 8, 9, 10, 11, 12, 13, 14, 15)); } } while (0)
#define PG8_LDB(dst, b, h) do { _Pragma("unroll") for (int n = 0; n < 2; ++n) { const bf16x8 lo_ = *(const PG8_LAS bf16x8*)(lds + PG8_SB(b, h) + boff + n * 2048), hi_ = *(const PG8_LAS bf16x8*)(lds + PG8_SB(b, h) + boff + n * 2048 + 16); dst[n] = __builtin_bit_cast(v8i, __builtin_shufflevector(lo_, hi_, 0, 1, 2, 3, 4, 5, 6, 7, 8, 9, 10, 11, 12, 13, 14, 15)); } } while (0)
#define PG8_MMA(ai, bj, At, Bt) do { __builtin_amdgcn_s_setprio(1); _Pragma("unroll") for (int m = 0; m < 4; ++m) _Pragma("unroll") for (int n = 0; n < 2; ++n) \
        asm volatile("v_mfma_scale_f32_16x16x128_f8f6f4 %0, %1, %2, %0, %3, %3 op_sel_hi:[0,0,0]" : "+v"(acc[ai][bj][m][n]) : "v"(Bt[n]), "v"(At[m]), "v"(scl_)); __builtin_amdgcn_s_setprio(0); } while (0)
#define PG8_WAIT_V(n) asm volatile("s_waitcnt vmcnt(" #n ")" ::: "memory")
#define PG8_WAIT_L(n) asm volatile("s_waitcnt lgkmcnt(" #n ")" ::: "memory")
#define PG8_BAR __builtin_amdgcn_s_barrier()
#define PG8_SCHED __builtin_amdgcn_sched_barrier(0)
    Unit cur, nxt; int ui = 0;
    if (!S.next(0, cur)) return;
    f32x4 acc[2][2][4][2];
#pragma unroll
    for (int a = 0; a < 2; ++a)
#pragma unroll
        for (int b = 0; b < 2; ++b)
#pragma unroll
            for (int m = 0; m < 4; ++m)
#pragma unroll
                for (int n = 0; n < 2; ++n) acc[a][b][m][n] = (f32x4){0.f, 0.f, 0.f, 0.f};
    v8i At[4], B0[2], B1[2];
    const char* cA = (const char*)g.A + (size_t)cur.pa * tstepA; const char* cB = (const char*)g.Bt + (size_t)cur.pb * tstepB;
    S.a_ready(cur);
    if constexpr (SP2) {
        PG8_STAGE(PG8_SB(0, 0), cB, voffB); PG8_STAGE(PG8_SB(0, 1), cB + hstepB, voffB); PG8_STAGE(PG8_SA(0, 0), cA, voffA); PG8_STAGE(PG8_SA(0, 1), cA + hstepA, voffA);
        if (wr == 1) PG8_BAR;
        PG8_WAIT_V(2); PG8_BAR;
        PG8_STAGE(PG8_SB(1, 0), cB + kstep, voffB); PG8_STAGE(PG8_SA(1, 0), cA + kstep, voffA); PG8_STAGE(PG8_SB(1, 1), cB + hstepB + kstep, voffB);
        PG8_WAIT_V(6); PG8_BAR;
    } else {
        PG8_STAGE(PG8_SB(0, 0), cB, voffB); PG8_STAGE(PG8_SA(0, 0), cA, voffA); PG8_STAGE(PG8_SB(0, 1), cB + hstepB, voffB); PG8_STAGE(PG8_SA(0, 1), cA + hstepA, voffA);
        if (wr == 1) PG8_BAR;
        PG8_WAIT_V(4); PG8_BAR;
        PG8_STAGE(PG8_SB(1, 0), cB + kstep, voffB); PG8_STAGE(PG8_SA(1, 0), cA + kstep, voffA); PG8_STAGE(PG8_SB(1, 1), cB + hstepB + kstep, voffB);
        PG8_WAIT_V(6); PG8_BAR;
    }
    for (;;) {
        const bool has_next = S.next(ui + 1, nxt);
        const char* nA = has_next ? (const char*)g.A + (size_t)nxt.pa * tstepA : cA; const char* nB = has_next ? (const char*)g.Bt + (size_t)nxt.pb * tstepB : cB;
        for (int t = 0; t < nt; t += 2) {
            const bool last = (t == nt - 2);
            const char* a1 = cA + (size_t)(t + 1) * kstep;
            const char* a2 = last ? nA : cA + (size_t)(t + 2) * kstep; const char* b2 = last ? nB : cB + (size_t)(t + 2) * kstep;
            const char* a3 = a2 + kstep; const char* b3 = b2 + kstep;
            if (last && has_next) S.a_ready(nxt);
            if constexpr (SP2) {
            PG8_LDB(B0, 0, 0); PG8_LDB(B1, 0, 1); PG8_SCHED; PG8_LDA(At, 0, 0); PG8_STAGE(PG8_SA(1, 1), a1 + hstepA, voffA);
            PG8_WAIT_V(8); PG8_WAIT_L(0); PG8_BAR; PG8_MMA(0, 0, At, B0); PG8_MMA(0, 1, At, B1); PG8_BAR; PG8_SCHED;
            PG8_LDA(At, 0, 1); PG8_STAGE(PG8_SB(0, 0), b2, voffB); PG8_STAGE(PG8_SB(0, 1), b2 + hstepB, voffB); PG8_STAGE(PG8_SA(0, 0), a2, voffA);
            PG8_WAIT_V(8); PG8_WAIT_L(0); PG8_BAR; PG8_MMA(1, 0, At, B0); PG8_MMA(1, 1, At, B1); PG8_BAR; PG8_SCHED;
            PG8_LDB(B0, 1, 0); PG8_LDB(B1, 1, 1); PG8_SCHED; PG8_LDA(At, 1, 0); PG8_STAGE(PG8_SA(0, 1), a2 + hstepA, voffA);
            PG8_WAIT_V(8); PG8_WAIT_L(0); PG8_BAR; PG8_MMA(0, 0, At, B0); PG8_MMA(0, 1, At, B1); PG8_BAR; PG8_SCHED;
            PG8_LDA(At, 1, 1); PG8_STAGE(PG8_SB(1, 0), b3, voffB); PG8_STAGE(PG8_SB(1, 1), b3 + hstepB, voffB); PG8_STAGE(PG8_SA(1, 0), a3, voffA);
            PG8_WAIT_V(8); PG8_WAIT_L(0); PG8_BAR; PG8_MMA(1, 0, At, B0); PG8_MMA(1, 1, At, B1); PG8_BAR; PG8_SCHED;
            } else {
            PG8_LDB(B0, 0, 0); PG8_SCHED; PG8_LDA(At, 0, 0); PG8_STAGE(PG8_SA(1, 1), a1 + hstepA, voffA);
            PG8_WAIT_L(8); PG8_BAR; PG8_WAIT_L(0); PG8_MMA(0, 0, At, B0); PG8_BAR; PG8_SCHED;
            PG8_LDB(B1, 0, 1); PG8_STAGE(PG8_SB(0, 0), b2, voffB);
            PG8_BAR; PG8_WAIT_L(0); PG8_MMA(0, 1, At, B1); PG8_BAR;
            PG8_LDA(At, 0, 1); PG8_STAGE(PG8_SA(0, 0), a2, voffA);
            PG8_BAR; PG8_WAIT_L(0); PG8_MMA(1, 0, At, B0); PG8_BAR; PG8_SCHED;
            PG8_STAGE(PG8_SB(0, 1), b2 + hstepB, voffB);
            PG8_WAIT_V(6); PG8_BAR; PG8_MMA(1, 1, At, B1); PG8_BAR;
            PG8_LDB(B0, 1, 0); PG8_SCHED; PG8_LDA(At, 1, 0); PG8_STAGE(PG8_SA(0, 1), a2 + hstepA, voffA);
            PG8_WAIT_L(8); PG8_BAR; PG8_WAIT_L(0); PG8_MMA(0, 0, At, B0); PG8_BAR; PG8_SCHED;
            PG8_LDB(B1, 1, 1); PG8_STAGE(PG8_SB(1, 0), b3, voffB);
            PG8_BAR; PG8_WAIT_L(0); PG8_MMA(0, 1, At, B1); PG8_BAR;
            PG8_LDA(At, 1, 1); PG8_STAGE(PG8_SA(1, 0), a3, voffA);
            PG8_BAR; PG8_WAIT_L(0); PG8_MMA(1, 0, At, B0); PG8_BAR; PG8_SCHED;
            PG8_STAGE(PG8_SB(1, 1), b3 + hstepB, voffB);
            PG8_WAIT_V(6); PG8_BAR; PG8_MMA(1, 1, At, B1); PG8_BAR;
            }
        }
        if constexpr (ALIGN_EPI) { if (wr == 0) PG8_BAR; }
        asm volatile("s_nop 15\n\ts_nop 15\n\ts_nop 7" ::: "memory");
        if constexpr (!Epi::AFTER_DRAIN) { E(acc, cur, wr, wc, fr, fq); S.done(cur); }
        if (!has_next) break;
#pragma unroll
        for (int a = 0; a < 2; ++a)
#pragma unroll
            for (int b = 0; b < 2; ++b)
#pragma unroll
                for (int m = 0; m < 4; ++m)
#pragma unroll
                    for (int n = 0; n < 2; ++n) acc[a][b][m][n] = (f32x4){0.f, 0.f, 0.f, 0.f};
        cur = nxt; cA = nA; cB = nB; ++ui;
        if constexpr (ALIGN_EPI) { if (wr == 1) PG8_BAR; }
    }
    PG8_WAIT_V(0);
    if constexpr (!ALIGN_EPI) { if (wr == 0) PG8_BAR; }
    PG8_BAR;
    if constexpr (Epi::AFTER_DRAIN) { E.fused(acc, cur, wr, wc, fr, fq, lds, wid, lane); S.done(cur); }
#undef PG8_SA
#undef PG8_SB
#undef PG8_STAGE
#undef PG8_RS_voffA
#undef PG8_RS_voffB
#undef PG8_LDA
#undef PG8_LDB
#undef PG8_MMA
#undef PG8_WAIT_V
#undef PG8_WAIT_L
#undef PG8_BAR
#undef PG8_SCHED
}
}
namespace mk {
constexpr int NWAVES = 8;
constexpr int M = 16384, D = 2048, NPROJ = 3584, INC = 3392, DFF = 5632, DFE = 7168, NE = 8;
constexpr int NH = 8, QKD = 192, HV = 128, QR = 512, KVR = 256;
constexpr int QLD = NH * QKD, VLD = NH * HV;
constexpr int P_U = 0, P_CQ = 512, P_CKV = 1024, P_KR = 1280, P_HQ = 1344, P_HF = 1856, P_HI = 2368, P_HG = 2880;
constexpr float ALPHA = 1.41421356237309515f, LN_EPS = 1e-5f, RMS_EPS = 1e-6f;
constexpr float QSCALE = 0.07216878364870322f * 1.4426950408889634f;

constexpr size_t MiB = 1u << 20;
constexpr size_t WS_CTL = 0, CTL_ZERO_BYTES = 1 * MiB;
constexpr size_t WS_SMALL = 1 * MiB;
constexpr size_t WS_ROPE = 9 * MiB;
constexpr size_t WS_WIN = 13 * MiB, WIN_L = 14 * MiB;
constexpr size_t WS_WOUT = 41 * MiB, WOUT_L = 8 * MiB;
constexpr size_t WS_WGLU = 57 * MiB, WGLU_L = MiB / 2;
constexpr size_t WS_WUQ = 58 * MiB, WUQ_L = 3 * MiB / 2;
constexpr size_t WS_WUKV = 61 * MiB, WUKV_L = 1 * MiB;
constexpr size_t WS_FFNGU = 63 * MiB, WS_FFND = 107 * MiB;
constexpr size_t WS_MOEGU = 129 * MiB, MOEGU_E = 56 * MiB, WS_MOED = 577 * MiB, MOED_E = 28 * MiB;
constexpr size_t WS_S5K = 801 * MiB, S5K_L = 72 * MiB, WS_S5H = 945 * MiB, S5H_L = 16 * MiB;
constexpr size_t WS_XB = 977 * MiB;
constexpr size_t WS_R0 = 1041 * MiB, WS_R1 = 1169 * MiB;
constexpr size_t WS_PROJ = 1297 * MiB;
constexpr size_t WS_Q = 1409 * MiB, WS_K = 1457 * MiB, WS_V = 1505 * MiB;
constexpr size_t WS_YCAT = 1537 * MiB;
constexpr size_t WS_U2 = 1601 * MiB, WS_E = 1619 * MiB, WS_YG = 1627 * MiB;
constexpr size_t WS_HGU = 1643 * MiB, WS_HGS = 1707 * MiB, WS_HGG = 1739 * MiB;
constexpr size_t WS_PRE = 1297 * MiB;
constexpr size_t WS_H = 1425 * MiB;
constexpr size_t WS_HM = 1169 * MiB, WS_XG = 1645 * MiB, WS_OS = 801 * MiB;
constexpr size_t WS_X8 = 353 * MiB;
constexpr size_t WS_XG8 = 385 * MiB;
constexpr size_t WS_S5PW = 453 * MiB;
constexpr float X8_SCALE = 16.f, W8_SCALE = 256.f, H8_SCALE = 8.f, WD8_SCALE = 1024.f;
constexpr float WI8_CLIP = 0.10f, WI8_Q = 127.f / WI8_CLIP, WI8_S = WI8_CLIP / 127.f;
constexpr size_t SM_XS = 1800 * 1024, SM_XGS = 1864 * 1024;
constexpr size_t WS_END = 1792 * MiB;
constexpr size_t SM_RSTDQ = 0, SM_RSTDKV = 64 * 1024, SM_LB = 128 * 1024  , SM_S5LB = 136 * 1024  ,
                 SM_S5BB = 200 * 1024  , SM_TIDX = 1024 * 1024  , SM_TW = 1280 * 1024  ,
                 SM_POS = 1536 * 1024  , SM_CNT = 1792 * 1024  , SM_MISC = 1800 * 1024,
                 SM_S5KC = 2048 * 1024  ;
constexpr int CW_TMO = 0, CW_CODE = 1, CW_BAR = 4096;

constexpr int RING_BYTES = 131072, LDSCTL_OFF = RING_BYTES, MISC_OFF = LDSCTL_OFF + 320, LDS_BYTES = 147456;

#define GAS __attribute__((address_space(1)))
#define LAS __attribute__((address_space(3)))
typedef unsigned short bf16;
typedef unsigned v4u __attribute__((ext_vector_type(4)));
typedef unsigned v2u __attribute__((ext_vector_type(2)));
typedef float f32x4 __attribute__((ext_vector_type(4)));
typedef float f32x16 __attribute__((ext_vector_type(16)));
typedef short bf16x8 __attribute__((ext_vector_type(8)));
typedef short s16x4 __attribute__((ext_vector_type(4)));
typedef GAS unsigned gu32;
#define RLX_AGENT __ATOMIC_RELAXED, __HIP_MEMORY_SCOPE_AGENT
#define LDS_WAIT() asm volatile("s_waitcnt lgkmcnt(0)" ::: "memory")
#define VM_WAIT() asm volatile("s_waitcnt vmcnt(0)" ::: "memory")
__device__ __forceinline__ unsigned f2bf(float f) { unsigned u = __builtin_bit_cast(unsigned, f); return (u + 0x7fffu + ((u >> 16) & 1u)) >> 16; }
__device__ __forceinline__ unsigned pk2(float lo, float hi) { return f2bf(lo) | (f2bf(hi) << 16); }
__device__ __forceinline__ float bf2f(unsigned short b) { return __builtin_bit_cast(float, (unsigned)b << 16); }
__device__ __forceinline__ float bflo(unsigned w) { return __builtin_bit_cast(float, w << 16); }
__device__ __forceinline__ float bfhi(unsigned w) { return __builtin_bit_cast(float, w & 0xffff0000u); }
__device__ __forceinline__ float sigmoidf_(float x) { return __builtin_amdgcn_rcpf(1.f + __expf(-x)); }
__device__ __forceinline__ float siluf_(float x) { return x * __builtin_amdgcn_rcpf(1.f + __expf(-x)); }

#define XB_TMO      128
#define XB_XCNT(j)  (256  + 64 * (j))
#define XB_XSUB(j)  (1280 + 64 * (j))
#define XB_XGEN(j)  (2304 + 64 * (j))
#define XB_TOP      3328
#define XB_TOPGEN   3392
#define XCD_BAR_WORDS 3456
#define XB_SPIN_CAP (1u << 18)
__device__ __forceinline__ unsigned xb_ld(unsigned* p)              { return __hip_atomic_load(p, __ATOMIC_RELAXED, __HIP_MEMORY_SCOPE_AGENT); }
__device__ __forceinline__ unsigned xb_add(unsigned* p, unsigned v) { return __hip_atomic_fetch_add(p, v, __ATOMIC_RELAXED, __HIP_MEMORY_SCOPE_AGENT); }
__device__ __forceinline__ unsigned xb_xcc_id() { return (unsigned)__builtin_amdgcn_s_getreg((3 << 11) | 20) & 0xFu; }
#define XB_SPIN(cond, bar) do { unsigned _sp = 0; while (cond) { __builtin_amdgcn_s_sleep(1); \
    if ((++_sp & 255u) == 0u) { if (xb_ld(&(bar)[XB_TMO])) break; if (_sp > XB_SPIN_CAP) { atomicAdd(&(bar)[XB_TMO], 1u); break; } } } } while (0)
struct XcdBarrier { unsigned* bar; unsigned x; volatile LAS unsigned* st; };
__device__ __forceinline__ XcdBarrier xcd_barrier_post(unsigned* bar, volatile LAS unsigned* st) {
    XcdBarrier b; b.bar = bar; b.x = xb_xcc_id(); b.st = st;
    if (threadIdx.x == 0) (void)xb_add(&bar[XB_XCNT(b.x)], 1u);
    return b;
}
__device__ __forceinline__ void xcd_barrier_complete(unsigned* bar, unsigned x, unsigned& nloc, unsigned& nx) {
    const unsigned G = gridDim.x * gridDim.y * gridDim.z;
    unsigned sum, cnt, mine, sp = 0u;
    for (;;) {
        sum = 0u; cnt = 0u; mine = 0u;
#pragma unroll
        for (unsigned j = 0; j < 16; ++j) { const unsigned c = xb_ld(&bar[XB_XCNT(j)]); sum += c; cnt += (c > 0u) ? 1u : 0u; }
        mine = xb_ld(&bar[XB_XCNT(x)]);
        if (sum == G) break;
        __builtin_amdgcn_s_sleep(1);
        if ((++sp & 255u) == 0u) { if (xb_ld(&bar[XB_TMO])) break; if (sp > XB_SPIN_CAP) { atomicAdd(&bar[XB_TMO], 1u); break; } }
    }
    nloc = mine > 0u ? mine : 1u; nx = cnt > 0u ? cnt : 1u;
}
__device__ __forceinline__ void xcd_barrier(const XcdBarrier& b) {
    asm volatile("s_waitcnt vmcnt(0)" ::: "memory");
    __syncthreads();
    if (threadIdx.x == 0) {
        unsigned* bar = b.bar;
        __builtin_amdgcn_s_waitcnt(0);
        unsigned nloc = b.st[0], nx = b.st[1];
        if (nloc == 0u) { xcd_barrier_complete(bar, b.x, nloc, nx); b.st[0] = nloc; b.st[1] = nx; }
        const unsigned old = xb_add(&bar[XB_XSUB(b.x)], 1u);
        const unsigned gen = old / nloc;
        if (old + 1u == (gen + 1u) * nloc) {
            __builtin_amdgcn_fence(__ATOMIC_RELEASE, "agent");
            asm volatile("s_waitcnt vmcnt(0)" ::: "memory");
            const unsigned og = xb_add(&bar[XB_TOP], 1u);
            const unsigned tg = og / nx;
            if (og + 1u == (tg + 1u) * nx) xb_add(&bar[XB_TOPGEN], 1u);
            else XB_SPIN(xb_ld(&bar[XB_TOPGEN]) == tg, bar);
            __builtin_amdgcn_fence(__ATOMIC_ACQUIRE, "agent");
            xb_add(&bar[XB_XGEN(b.x)], 1u);
            asm volatile("s_waitcnt vmcnt(0)" ::: "memory");
        } else {
            XB_SPIN(xb_ld(&bar[XB_XGEN(b.x)]) == gen, bar);
            __builtin_amdgcn_fence(__ATOMIC_ACQUIRE, "agent");
            asm volatile("s_waitcnt vmcnt(0)" ::: "memory");
        }
    }
    __syncthreads();
}

struct Frame {
    LAS unsigned char* lds;
    volatile LAS unsigned* MISC;
    gu32* ctl;
    int wave, G, gw, NGW;
    unsigned char* ws;
};
__device__ __forceinline__ int opq(int v) { asm volatile("" : "+v"(v)); return v; }
__device__ __forceinline__ int opq_s(int v) { asm volatile("" : "+s"(v)); return v; }
__device__ __forceinline__ float wave_sum(float v) {
#pragma unroll
    for (int o = 1; o < 64; o <<= 1) v += __shfl_xor(v, o);
    return v;
}

template <int MODE> __device__ __forceinline__ int dst_row(int n, int off) {
    if (MODE == 0) return n + off;
    if (MODE == 1) { const int h = n / QKD, d = n % QKD; if (d < 128) return h * 128 + d; const int j = d - 128; return 1024 + (h >> 2) * 256 + ((j >> 5) << 7) + (h & 3) * 32 + (j & 31); }
    if (MODE == 2) return ((n >> 7) << 8) + (n & 127);
    return ((n >> 7) << 8) + 128 + (n & 127);
}
__device__ __forceinline__ void tr_load(f32x4 (&ld)[8], const float* __restrict__ W, int N, int ldw, int item, int lane) {
    const int nblk = N / 32, kb = item / nblk, nb = item % nblk, k0 = 64 * kb, n0 = 32 * nb;
#pragma unroll
    for (int i = 0; i < 8; ++i) ld[i] = *(const GAS f32x4*)(W + (size_t)(k0 + (lane >> 3) + 8 * i) * ldw + n0 + 4 * (lane & 7));
}
template <int MODE> __device__ __forceinline__ void tr_store(const f32x4 (&ld)[8], int K, int N, bf16* __restrict__ WT, int off, const float* __restrict__ kscale, float sc, LAS float* scr, int item, int lane) {
    const int nblk = N / 32, kb = item / nblk, nb = item % nblk, k0 = 64 * kb, n0 = 32 * nb;
#pragma unroll
    for (int i = 0; i < 8; ++i) { const int kk = (lane >> 3) + 8 * i; float s = sc; if (kscale) s *= kscale[k0 + kk]; LAS float* d = scr + kk * 33 + 4 * (lane & 7);
        d[0] = ld[i].x * s; d[1] = ld[i].y * s; d[2] = ld[i].z * s; d[3] = ld[i].w * s; }
    LDS_WAIT(); asm volatile("" ::: "memory");
    const int c = lane & 7;
#pragma unroll
    for (int j = 0; j < 4; ++j) { const int n = (lane >> 3) + 8 * j; const LAS float* s = scr + (8 * c) * 33 + n;
        v4u o; o.x = pk2(s[0 * 33], s[1 * 33]); o.y = pk2(s[2 * 33], s[3 * 33]); o.z = pk2(s[4 * 33], s[5 * 33]); o.w = pk2(s[6 * 33], s[7 * 33]);
        *(GAS v4u*)(WT + (size_t)dst_row<MODE>(n0 + n, off) * K + k0 + 8 * c) = o; }
    LDS_WAIT(); asm volatile("" ::: "memory");
}
template <int MODE> __device__ __forceinline__ void transpose_job(Frame& F, const float* W, int K, int N, int ldw, bf16* WT, int off, const float* kscale, float sc) {
    LAS float* scr = (LAS float*)(F.lds + F.wave * 16384);
    const int nitems = (K / 64) * (N / 32), lane = (opq((int)threadIdx.x) & 63);
    int it = opq_s(F.gw); if (it >= nitems) return;
    f32x4 ld[8], nx[8]; tr_load(ld, W, N, ldw, it, lane);
    for (; it < nitems; it += F.NGW) {
        const int itn = (it + F.NGW < nitems) ? it + F.NGW : it; tr_load(nx, W, N, ldw, itn, lane);
        tr_store<MODE>(ld, K, N, WT, off, kscale, sc, scr, it, lane);
#pragma unroll
        for (int i = 0; i < 8; ++i) ld[i] = nx[i]; }
}
__device__ __forceinline__ unsigned pk4_fp8(float a, float b, float c, float d) { int w = 0; w = __builtin_amdgcn_cvt_pk_fp8_f32(a, b, w, false); w = __builtin_amdgcn_cvt_pk_fp8_f32(c, d, w, true); return (unsigned)w; }
__device__ __forceinline__ unsigned pk4_i8(float a, float b, float c, float d) {
    const int ia = (int)rintf(fminf(fmaxf(a, -127.f), 127.f)), ib = (int)rintf(fminf(fmaxf(b, -127.f), 127.f)), ic = (int)rintf(fminf(fmaxf(c, -127.f), 127.f)), id = (int)rintf(fminf(fmaxf(d, -127.f), 127.f));
    return (unsigned)(ia & 255) | ((unsigned)(ib & 255) << 8) | ((unsigned)(ic & 255) << 16) | ((unsigned)id << 24);
}
__device__ __forceinline__ float wave_max(float v) {
#pragma unroll
    for (int o = 1; o < 64; o <<= 1) v = fmaxf(v, __shfl_xor(v, o));
    return v;
}
template <int MODE, bool I8> __device__ __forceinline__ void tr_store8(const f32x4 (&ld)[8], int K, int N, unsigned char* __restrict__ WT, float sc, LAS float* scr, int item, int lane) {
    const int nblk = N / 32, kb = item / nblk, nb = item % nblk, k0 = 64 * kb, n0 = 32 * nb;
#pragma unroll
    for (int i = 0; i < 8; ++i) { const int kk = (lane >> 3) + 8 * i; LAS float* d = scr + kk * 33 + 4 * (lane & 7); d[0] = ld[i].x * sc; d[1] = ld[i].y * sc; d[2] = ld[i].z * sc; d[3] = ld[i].w * sc; }
    LDS_WAIT(); asm volatile("" ::: "memory");
#pragma unroll
    for (int ps = 0; ps < 2; ++ps) { const int n = (lane >> 2) + 16 * ps, c = lane & 3; const LAS float* s = scr + (16 * c) * 33 + n;
        v4u o;
        if (I8) { o.x = pk4_i8(s[0 * 33], s[1 * 33], s[2 * 33], s[3 * 33]); o.y = pk4_i8(s[4 * 33], s[5 * 33], s[6 * 33], s[7 * 33]); o.z = pk4_i8(s[8 * 33], s[9 * 33], s[10 * 33], s[11 * 33]); o.w = pk4_i8(s[12 * 33], s[13 * 33], s[14 * 33], s[15 * 33]); }
        else { o.x = pk4_fp8(s[0 * 33], s[1 * 33], s[2 * 33], s[3 * 33]); o.y = pk4_fp8(s[4 * 33], s[5 * 33], s[6 * 33], s[7 * 33]); o.z = pk4_fp8(s[8 * 33], s[9 * 33], s[10 * 33], s[11 * 33]); o.w = pk4_fp8(s[12 * 33], s[13 * 33], s[14 * 33], s[15 * 33]); }
        *(GAS v4u*)(WT + (size_t)dst_row<MODE>(n0 + n, 0) * K + k0 + 16 * c) = o; }
    LDS_WAIT(); asm volatile("" ::: "memory");
}
template <int MODE> __device__ __forceinline__ void transpose_item8(const float* __restrict__ W, int K, int N, int ldw, unsigned char* __restrict__ WT, float sc, LAS float* scr, int item, int lane) {
    f32x4 ld[8]; tr_load(ld, W, N, ldw, item, lane); tr_store8<MODE, false>(ld, K, N, WT, sc, scr, item, lane);
}
template <int MODE, bool I8> __device__ __forceinline__ void transpose_job8(Frame& F, const float* W, int K, int N, int ldw, unsigned char* WT, float sc) {
    LAS float* scr = (LAS float*)(F.lds + F.wave * 16384);
    const int nitems = (K / 64) * (N / 32), lane = (opq((int)threadIdx.x) & 63);
    int it = opq_s(F.gw); if (it >= nitems) return;
    f32x4 ld[8], nx[8]; tr_load(ld, W, N, ldw, it, lane);
    for (; it < nitems; it += F.NGW) {
        const int itn = (it + F.NGW < nitems) ? it + F.NGW : it; tr_load(nx, W, N, ldw, itn, lane);
        tr_store8<MODE, I8>(ld, K, N, WT, sc, scr, it, lane);
#pragma unroll
        for (int i = 0; i < 8; ++i) ld[i] = nx[i]; }
}
__device__ __forceinline__ void quant_rows_job(Frame& F, const float* __restrict__ src, unsigned char* __restrict__ X8, float* __restrict__ XS, int rows) {
    const int lane = (opq((int)threadIdx.x) & 63);
    for (int t = opq_s(F.gw); t < rows; t += F.NGW) {
        f32x4 v[8]; float am = 0.f;
#pragma unroll
        for (int j = 0; j < 8; ++j) { v[j] = *(const GAS f32x4*)(src + (size_t)t * D + (j * 64 + lane) * 4); am = fmaxf(am, fmaxf(fmaxf(fabsf(v[j].x), fabsf(v[j].y)), fmaxf(fabsf(v[j].z), fabsf(v[j].w)))); }
        am = fmaxf(wave_max(am), 1e-20f); const float q = 127.f / am; if (lane == 0) XS[t] = am * (1.f / 127.f);
#pragma unroll
        for (int j = 0; j < 8; ++j) *(GAS unsigned*)(X8 + (size_t)t * D + (j * 64 + lane) * 4) = pk4_i8(v[j].x * q, v[j].y * q, v[j].z * q, v[j].w * q);
    }
}
__device__ __forceinline__ void cvt_job(Frame& F, const float* __restrict__ src, bf16* __restrict__ dst, size_t n) {
    const size_t nth = (size_t)F.NGW * 64, t0 = (size_t)opq_s(F.gw) * 64 + (opq((int)threadIdx.x) & 63);
    for (size_t i = t0; i < n / 8; i += nth) { const f32x4 a = *(const GAS f32x4*)(src + i * 8), b = *(const GAS f32x4*)(src + i * 8 + 4);
        v4u o; o.x = pk2(a.x, a.y); o.y = pk2(a.z, a.w); o.z = pk2(b.x, b.y); o.w = pk2(b.z, b.w); *(GAS v4u*)(dst + i * 8) = o; }
}
__device__ __forceinline__ void zero_job(Frame& F, void* dst, size_t bytes) {
    const size_t nth = (size_t)F.NGW * 64, t0 = (size_t)opq_s(F.gw) * 64 + (opq((int)threadIdx.x) & 63); const unsigned zz = (unsigned)opq(0); const v4u z = {zz, zz, zz, zz};
    for (size_t i = t0; i < bytes / 16; i += nth) ((GAS v4u*)dst)[i] = z;
}

struct EpiProj {
    static constexpr bool PERM = true, AFTER_DRAIN = false;
    bf16* P; bf16* U2; float sc; const float* rs;
    __device__ __forceinline__ void operator()(const pg8::f32x4 (&acc)[2][2][4][2], const pg8::Unit& u, int wr, int wc, int fr, int fq) const {
        { const int ln_ = opq((int)threadIdx.x) & 63; fr = ln_ & 15; fq = ln_ >> 4; }
        float rsv[8];
#pragma unroll
        for (int k = 0; k < 8; ++k) rsv[k] = rs[u.pm * 256 + (k >> 2) * 128 + wr * 64 + (k & 3) * 16 + fr];
#pragma unroll
        for (int ai = 0; ai < 2; ++ai)
#pragma unroll
            for (int m = 0; m < 4; ++m) { const int row = u.pm * 256 + ai * 128 + wr * 64 + m * 16 + fr; const float s1 = sc * rsv[ai * 4 + m];
#pragma unroll
                for (int bj = 0; bj < 2; ++bj) { const pg8::f32x4 v0 = acc[ai][bj][m][0] * s1, v1 = acc[ai][bj][m][1] * s1;
                    v4u w; w.x = pg8::cvt_pk_bf16(v0[0], v0[1]); w.y = pg8::cvt_pk_bf16(v0[2], v0[3]); w.z = pg8::cvt_pk_bf16(v1[0], v1[1]); w.w = pg8::cvt_pk_bf16(v1[2], v1[3]);
                    const int col = u.pn * 256 + bj * 128 + wc * 32 + 8 * fq;
                    if (u.pn < 2) { const int g = col >> 4, cc = col & 15, chunk = row >> 6, s = row & 63; *(GAS v4u*)(U2 + ((size_t)(g * 256 + chunk) * 1152 + s * 16 + cc)) = w; }
                    else *(GAS v4u*)(P + (size_t)row * NPROJ + col) = w; } }
    }
};
template <bool KV> struct EpiRS {
    static constexpr bool PERM = true, AFTER_DRAIN = false;
    bf16* O1; unsigned char* K8; unsigned char* V8; const float* rstd;
    __device__ __forceinline__ void operator()(const pg8::f32x4 (&acc)[2][2][4][2], const pg8::Unit& u, int wr, int wc, int fr, int fq) const {
        { const int ln_ = opq((int)threadIdx.x) & 63; fr = ln_ & 15; fq = ln_ >> 4; }
        float rsv[8];
#pragma unroll
        for (int k = 0; k < 8; ++k) rsv[k] = rstd[u.pm * 256 + (k >> 2) * 128 + wr * 64 + (k & 3) * 16 + fr];
#pragma unroll
        for (int ai = 0; ai < 2; ++ai)
#pragma unroll
            for (int m = 0; m < 4; ++m) { const int row = u.pm * 256 + ai * 128 + wr * 64 + m * 16 + fr; const float rs = KV ? rsv[ai * 4 + m] * 16.f : rsv[ai * 4 + m];
#pragma unroll
                for (int bj = 0; bj < 2; ++bj) { const pg8::f32x4 v0 = acc[ai][bj][m][0] * rs, v1 = acc[ai][bj][m][1] * rs;
                    if (!KV) { v4u w; w.x = pg8::cvt_pk_bf16(v0[0], v0[1]); w.y = pg8::cvt_pk_bf16(v0[2], v0[3]); w.z = pg8::cvt_pk_bf16(v1[0], v1[1]); w.w = pg8::cvt_pk_bf16(v1[2], v1[3]);
                        *(GAS v4u*)(O1 + (size_t)row * QLD + u.pn * 256 + bj * 128 + wc * 32 + 8 * fq) = w; }
                    else { v2u w; w.x = pk4_fp8(v0[0], v0[1], v0[2], v0[3]); w.y = pk4_fp8(v1[0], v1[1], v1[2], v1[3]);
                        if (bj == 0) *(GAS v2u*)(K8 + (size_t)row * QLD + u.pn * QKD + wc * 32 + 8 * fq) = w;
                        else *(GAS v2u*)(V8 + (size_t)row * VLD + u.pn * HV + wc * 32 + 8 * fq) = w; } }
                asm volatile("" ::: "memory"); }
    }
};

__device__ __forceinline__ void thin_mla(Frame& F, const bf16* __restrict__ P, float* __restrict__ rq, float* __restrict__ rkv, unsigned char* __restrict__ Kb, const float2* __restrict__ rope) {
    const int lane = (opq((int)threadIdx.x) & 63), gw0 = opq_s(F.gw);
    for (int tb = gw0; tb < M; tb += 4 * F.NGW) {
        v4u a[4], b[4]; unsigned short k1[4], k2[4]; float2 cs[4];
#pragma unroll
        for (int k = 0; k < 4; ++k) { const int t = tb + k * F.NGW; if (t < M) { const bf16* p = P + (size_t)t * NPROJ;
            a[k] = *(const GAS v4u*)(p + P_CQ + lane * 8);
            if (lane < 32) { b[k] = *(const GAS v4u*)(p + P_CKV + lane * 8); k1[k] = *(const GAS unsigned short*)(p + P_KR + lane); k2[k] = *(const GAS unsigned short*)(p + P_KR + 32 + lane); cs[k] = rope[(size_t)t * 32 + lane]; } } }
#pragma unroll
        for (int k = 0; k < 4; ++k) { const int t = tb + k * F.NGW; if (t < M) {
            float s = 0.f;
            { const unsigned w[4] = {a[k].x, a[k].y, a[k].z, a[k].w};
#pragma unroll
              for (int i = 0; i < 4; ++i) { const float lo = bflo(w[i]), hi = bfhi(w[i]); s += lo * lo + hi * hi; } }
            float s2 = 0.f;
            if (lane < 32) { const unsigned w[4] = {b[k].x, b[k].y, b[k].z, b[k].w};
#pragma unroll
              for (int i = 0; i < 4; ++i) { const float lo = bflo(w[i]), hi = bfhi(w[i]); s2 += lo * lo + hi * hi; } }
            s = wave_sum(s); s2 = wave_sum(s2);
            if (lane == 0) { rq[t] = rsqrtf(s * (1.f / QR) + RMS_EPS); rkv[t] = rsqrtf(s2 * (1.f / KVR) + RMS_EPS); }
            if (lane < 32) { const float x1 = __uint_as_float((unsigned)k1[k] << 16), x2 = __uint_as_float((unsigned)k2[k] << 16);
                const unsigned yy = pk4_fp8((x1 * cs[k].x - x2 * cs[k].y) * 16.f, (x1 * cs[k].y + x2 * cs[k].x) * 16.f, 0.f, 0.f); const unsigned char y1 = (unsigned char)(yy & 255u), y2 = (unsigned char)((yy >> 8) & 255u);
#pragma unroll
                for (int h = 0; h < NH; ++h) { unsigned char* kp = Kb + (size_t)t * QLD + h * QKD + 128; kp[32 * (lane >> 4) + (lane & 15)] = y1; kp[32 * (lane >> 4) + 16 + (lane & 15)] = y2; } } } }
    }
}
namespace at {
constexpr int KROW = 400, SHM_K = 64 * KROW, SHM_V = 64 * 128 * 2;
constexpr int OFF_V = 0, OFF_K = 3 * SHM_V, OFF_WS = OFF_K + 2 * SHM_K, LDS_NEED = OFF_WS + 8 * 256;
constexpr float THR = 8.f;
__device__ __forceinline__ int v_st(int k, int c) { const int kk = (k & ~0xC) | ((k & 4) << 1) | ((k & 8) >> 1); return ((kk >> 3) * 4 + (c >> 5)) * 512 + ((kk & 7) * 32 + (c & 31)) * 2; }
__device__ __forceinline__ int v_rd_base(int lane) { return ((lane & 3) << 3) | (((lane >> 2) & 3) << 6) | (((lane >> 4) & 1) << 5) | (((lane >> 5) & 1) << 8); }
constexpr int v_rd_off(int d0, int ks, int half) { return d0 * 512 + ks * 4096 + half * 2048; }
__device__ __forceinline__ int crow(int r, int hi) { return (r & 3) + 8 * (r >> 2) + 4 * hi; }
__device__ __forceinline__ unsigned cvtpk(float lo, float hi) { unsigned r; asm volatile("v_cvt_pk_bf16_f32 %0, %1, %2" : "=v"(r) : "v"(lo), "v"(hi)); return r; }
__device__ __forceinline__ void mask_tile(f32x16& p0, f32x16& p1, int dq) {
    const float NEG = -__builtin_inff();
#pragma unroll
    for (int r = 0; r < 16; ++r) { const int c = (r & 3) + 8 * (r >> 2); if (dq - c < 0) p0[r] = NEG; if (dq - c - 32 < 0) p1[r] = NEG; }
}
__device__ __forceinline__ void qkt(f32x16& p0, f32x16& p1, const LAS char* kb, const bf16x8* qr, float negm) {
    const int ka = (int)(unsigned)(uintptr_t)kb;
#define KRD(dst, off) asm volatile("ds_read_b128 %0, %1 offset:%2" : "=&v"(dst) : "v"(ka), "i"(off) : "memory")
#define KW(n) asm volatile("s_waitcnt lgkmcnt(" #n ")" ::: "memory")
#define QK2(x0, x1, d0) do { __builtin_amdgcn_sched_barrier(0); p0 = __builtin_amdgcn_mfma_f32_32x32x16_bf16(x0, qr[d0], p0, 0, 0, 0); p1 = __builtin_amdgcn_mfma_f32_32x32x16_bf16(x1, qr[d0], p1, 0, 0, 0); __builtin_amdgcn_sched_barrier(0); } while (0)
    bf16x8 a0, a1, b0, b1, c0, c1;
    KRD(a0, 0); KRD(a1, 32 * KROW); KRD(b0, 32); KRD(b1, 32 * KROW + 32);
    { float z_ = negm; asm volatile("" : "+v"(z_));
#pragma unroll
      for (int r = 0; r < 16; ++r) { p0[r] = z_; p1[r] = z_; } }
    __builtin_amdgcn_s_setprio(1);
    KRD(c0, 64);  KRD(c1, 32 * KROW + 64);  KW(4); QK2(a0, a1, 0);
    KRD(a0, 96);  KRD(a1, 32 * KROW + 96);  KW(4); QK2(b0, b1, 1);
    KRD(b0, 128); KRD(b1, 32 * KROW + 128); KW(4); QK2(c0, c1, 2);
    KRD(c0, 160); KRD(c1, 32 * KROW + 160); KW(4); QK2(a0, a1, 3);
    KRD(a0, 192); KRD(a1, 32 * KROW + 192); KW(4); QK2(b0, b1, 4);
    KRD(b0, 224); KRD(b1, 32 * KROW + 224); KW(4); QK2(c0, c1, 5);
    KRD(c0, 256); KRD(c1, 32 * KROW + 256); KW(4); QK2(a0, a1, 6);
    KRD(a0, 288); KRD(a1, 32 * KROW + 288); KW(4); QK2(b0, b1, 7);
    KRD(b0, 320); KRD(b1, 32 * KROW + 320); KW(4); QK2(c0, c1, 8);
    KRD(c0, 352); KRD(c1, 32 * KROW + 352); KW(4); QK2(a0, a1, 9);
    KW(2); QK2(b0, b1, 10);
    KW(0); QK2(c0, c1, 11);
    __builtin_amdgcn_s_setprio(0);
#undef KRD
#undef KW
#undef QK2
}
__device__ __forceinline__ void pv_tile(f32x16* o, int vb0, bf16x8 pa0, bf16x8 pa1, bf16x8 pa2, bf16x8 pa3) {
#define TRRD(dst, off) asm volatile("ds_read_b64_tr_b16 %0, %1 offset:%2" : "=&v"(dst) : "v"(vb0), "i"(off) : "memory")
#define PV_D0(d0) do { s16x4 l0, l1, l2, l3, h0, h1, h2, h3; constexpr int b_ = OFF_V + v_rd_off(d0, 0, 0); \
        TRRD(l0, b_); TRRD(h0, b_ + 2048); TRRD(l1, b_ + 4096); TRRD(h1, b_ + 6144); TRRD(l2, b_ + 8192); TRRD(h2, b_ + 10240); TRRD(l3, b_ + 12288); TRRD(h3, b_ + 14336); \
        asm volatile("s_waitcnt lgkmcnt(0)" ::: "memory"); __builtin_amdgcn_sched_barrier(0); \
        o[d0] = __builtin_amdgcn_mfma_f32_32x32x16_bf16(pa0, (bf16x8){l0[0], l0[1], l0[2], l0[3], h0[0], h0[1], h0[2], h0[3]}, o[d0], 0, 0, 0); \
        o[d0] = __builtin_amdgcn_mfma_f32_32x32x16_bf16(pa1, (bf16x8){l1[0], l1[1], l1[2], l1[3], h1[0], h1[1], h1[2], h1[3]}, o[d0], 0, 0, 0); \
        o[d0] = __builtin_amdgcn_mfma_f32_32x32x16_bf16(pa2, (bf16x8){l2[0], l2[1], l2[2], l2[3], h2[0], h2[1], h2[2], h2[3]}, o[d0], 0, 0, 0); \
        o[d0] = __builtin_amdgcn_mfma_f32_32x32x16_bf16(pa3, (bf16x8){l3[0], l3[1], l3[2], l3[3], h3[0], h3[1], h3[2], h3[3]}, o[d0], 0, 0, 0); } while (0)
    __builtin_amdgcn_s_setprio(1); PV_D0(0); PV_D0(1); PV_D0(2); PV_D0(3); __builtin_amdgcn_s_setprio(0);
#undef PV_D0
#undef TRRD
}
__device__ __forceinline__ void attn_unit(int h, int qb, const bf16* __restrict__ Q, const bf16* __restrict__ Kg, const bf16* __restrict__ Vg, const float2* __restrict__ rope, bf16* __restrict__ Y, int yld, int ycol0, LAS char* lds) {
    int tid_ = threadIdx.x; asm volatile("" : "+v"(tid_));
    const int tid = tid_, wid = __builtin_amdgcn_readfirstlane(tid >> 6), lane = tid & 63, r32 = lane & 31, hi = lane >> 5;
    const int NT = 4 * (qb + 1);
    const int q0 = qb * 256, qlo = q0 + wid * 32, qm = qlo + r32 - 4 * hi;
    LAS float* wsf = (LAS float*)(lds + OFF_WS) + wid * 64; LAS float* li_l = wsf; LAS float* al_l = wsf + 32;
    int krow[3], kch[3];
#pragma unroll
    for (int j = 0; j < 3; ++j) { const int id = tid + 512 * j; krow[j] = id / 24; kch[j] = id % 24; }
    const int sr = tid >> 4, sc = (tid & 15) * 8, vst0 = v_st(sr, sc), vst1 = v_st(32 + sr, sc);
    const bf16* Kh = Kg + h * QKD; const bf16* Vh = Vg + h * HV;
    v4u stK[3], stV[2];
#define A_LOAD(t) do { const int k0_ = (t) * 64; _Pragma("unroll") for (int j = 0; j < 3; ++j) stK[j] = *(const GAS v4u*)(Kh + (size_t)(k0_ + krow[j]) * QLD + kch[j] * 8); \
        stV[0] = *(const GAS v4u*)(Vh + (size_t)(k0_ + sr) * VLD + sc); stV[1] = *(const GAS v4u*)(Vh + (size_t)(k0_ + 32 + sr) * VLD + sc); } while (0)
#define A_WRITE(kbf, vbf) do { _Pragma("unroll") for (int j = 0; j < 3; ++j) *(LAS v4u*)(lds + OFF_K + (kbf) * SHM_K + krow[j] * KROW + kch[j] * 16) = stK[j]; \
        *(LAS v4u*)(lds + OFF_V + (vbf) * SHM_V + vst0) = stV[0]; *(LAS v4u*)(lds + OFF_V + (vbf) * SHM_V + vst1) = stV[1]; } while (0)
    A_LOAD(0);
    bf16x8 qr[12];
#pragma unroll
    for (int d0 = 0; d0 < 12; ++d0) qr[d0] = *(const GAS bf16x8*)(Q + (size_t)(qlo + r32) * QLD + h * QKD + d0 * 16 + hi * 8);
    VM_WAIT(); A_WRITE(0, 0);
    { const float2* cs = rope + (size_t)(qlo + r32) * 32 + hi * 8;
#pragma unroll
      for (int f = 0; f < 2; ++f) { v4u x1 = __builtin_bit_cast(v4u, qr[8 + f]), x2 = __builtin_bit_cast(v4u, qr[10 + f]); unsigned* a1 = (unsigned*)&x1; unsigned* a2 = (unsigned*)&x2;
#pragma unroll
          for (int w = 0; w < 4; ++w) { const f32x4 c2 = *(const GAS f32x4*)(cs + f * 16 + 2 * w);
              const float l1 = bflo(a1[w]), h1 = bfhi(a1[w]), l2 = bflo(a2[w]), h2 = bfhi(a2[w]);
              a1[w] = cvtpk(l1 * c2.x - l2 * c2.y, h1 * c2.z - h2 * c2.w); a2[w] = cvtpk(l1 * c2.y + l2 * c2.x, h1 * c2.w + h2 * c2.z); }
          qr[8 + f] = __builtin_bit_cast(bf16x8, x1); qr[10 + f] = __builtin_bit_cast(bf16x8, x2); } }
    __syncthreads();
    float m_reg = 0.f, l_reg = 0.f; f32x16 o[4];
    { float z_ = 0.f; asm volatile("" : "+v"(z_));
#pragma unroll
      for (int d_ = 0; d_ < 4; ++d_)
#pragma unroll
          for (int r = 0; r < 16; ++r) o[d_][r] = z_; }
    const LAS char* kbase = lds + OFF_K + r32 * KROW + hi * 16;
    const int vb0 = (int)(unsigned)(uintptr_t)lds + v_rd_base(lane);
#define PK4(P, B_, OUT) do { unsigned a0 = cvtpk(P[B_+0], P[B_+1]), a1 = cvtpk(P[B_+2], P[B_+3]), b0 = cvtpk(P[B_+4], P[B_+5]), b1 = cvtpk(P[B_+6], P[B_+7]); \
        auto r0 = __builtin_amdgcn_permlane32_swap(a0, b0, false, false); auto r1 = __builtin_amdgcn_permlane32_swap(a1, b1, false, false); \
        v4u w = {r0[0], r1[0], r0[1], r1[1]}; OUT = __builtin_bit_cast(bf16x8, w); } while (0)
    constexpr bool stag = false;
    bf16x8 pa0, pa1, pa2, pa3; pa0 = pa1 = pa2 = pa3 = (bf16x8){0, 0, 0, 0, 0, 0, 0, 0};
    int vcur = 0, vprev = 2;
    for (int t = 0; t <= NT; ++t) {
        if (t + 1 < NT) A_LOAD(t + 1);
        if (stag && t > 0) pv_tile(o, vb0 + vprev * SHM_V, pa0, pa1, pa2, pa3);
        if (t < NT) {
            f32x16 p0, p1; qkt(p0, p1, kbase + (t & 1) * SHM_K, qr, -m_reg);
            { const int kb_ = t * 64; if (kb_ + 63 > qlo) mask_tile(p0, p1, qm - kb_); }
            float pmax = p0[0];
#pragma unroll
            for (int r = 1; r < 16; ++r) pmax = fmaxf(pmax, p0[r]);
#pragma unroll
            for (int r = 0; r < 16; ++r) pmax = fmaxf(pmax, p1[r]);
            { auto rr = __builtin_amdgcn_permlane32_swap(__float_as_uint(pmax), __float_as_uint(pmax), false, false); pmax = fmaxf(__uint_as_float(rr[0]), __uint_as_float(rr[1])); }
            float alpha = 1.f;
            if (!__all(pmax <= THR)) {
                const float dm = fmaxf(pmax, 0.f); alpha = __builtin_amdgcn_exp2f(-dm); m_reg += dm;
#pragma unroll
                for (int r = 0; r < 16; ++r) { p0[r] -= dm; p1[r] -= dm; } }
#pragma unroll
            for (int r = 0; r < 16; ++r) { p0[r] = __builtin_amdgcn_exp2f(p0[r]); p1[r] = __builtin_amdgcn_exp2f(p1[r]); }
            typedef float f32x2v __attribute__((ext_vector_type(2)));
            f32x2v s2 = (f32x2v){p0[0], p0[1]} + (f32x2v){p1[0], p1[1]};
#pragma unroll
            for (int r = 2; r < 16; r += 2) s2 += (f32x2v){p0[r], p0[r + 1]} + (f32x2v){p1[r], p1[r + 1]};
            float ps = s2.x + s2.y;
            { auto rr = __builtin_amdgcn_permlane32_swap(__float_as_uint(ps), __float_as_uint(ps), false, false); ps = __uint_as_float(rr[0]) + __uint_as_float(rr[1]); }
            l_reg = l_reg * alpha + ps;
            PK4(p0, 0, pa0); PK4(p0, 8, pa1); PK4(p1, 0, pa2); PK4(p1, 8, pa3);
            if (__any(alpha < 1.f)) { if (hi == 0) al_l[r32] = alpha; LDS_WAIT();
#pragma unroll
                for (int d_ = 0; d_ < 4; ++d_)
#pragma unroll
                    for (int r = 0; r < 16; ++r) o[d_][r] *= al_l[crow(r, hi)]; }
            if (!stag) pv_tile(o, vb0 + vcur * SHM_V, pa0, pa1, pa2, pa3);
        }
        const int vnext = (vcur == 2) ? 0 : vcur + 1;
        if (t + 1 < NT) { VM_WAIT(); A_WRITE((t + 1) & 1, vnext); }
        vprev = vcur; vcur = vnext;
        __syncthreads();
    }
#undef PK4
#undef A_LOAD
#undef A_WRITE
    if (hi == 0) li_l[r32] = l_reg; LDS_WAIT();
    bf16* Yw = Y + (size_t)qlo * yld + ycol0 + h * HV;
#pragma unroll
    for (int r = 0; r < 16; ++r) { const int orow = crow(r, hi); const float il = 1.f / li_l[orow];
#pragma unroll
        for (int d0 = 0; d0 < 4; ++d0) { const float v = o[d0][r] * il; const float vn = __shfl_xor(v, 1);
            if ((r32 & 1) == 0) *(GAS unsigned*)(Yw + (size_t)orow * yld + d0 * 32 + r32) = cvtpk(v, vn); } }
    __syncthreads();
}
}
namespace at8 {
typedef int v8i __attribute__((ext_vector_type(8)));
constexpr int KROW = 208, SHM_K = 64 * KROW, VROW = 80, SHM_V = 128 * VROW;
constexpr int OFF_K = 0, OFF_V = 4 * SHM_K, OFF_WS = OFF_V + 4 * SHM_V;
constexpr float THR = 2.f, POFF = 6.f;
constexpr int SC_Q = 0x79797979, SC_K = 0x7b7b7b7b, SC_V = 0x7b7b7b7b, SC_1 = 0x7f7f7f7f;
__device__ __forceinline__ unsigned pk4(float a, float b, float c, float d) { int w = 0; w = __builtin_amdgcn_cvt_pk_fp8_f32(a, b, w, false); w = __builtin_amdgcn_cvt_pk_fp8_f32(c, d, w, true); return (unsigned)w; }
__device__ __forceinline__ f32x16 mfma8(v8i a, v8i b, f32x16 c, int sa, int sb) { return __builtin_amdgcn_mfma_scale_f32_32x32x64_f8f6f4(a, b, c, 0, 0, 0, sa, 0, sb); }
__device__ __forceinline__ v8i ld32(const LAS char* p) { const v4u lo = *(const LAS v4u*)p, hi = *(const LAS v4u*)(p + 16); return (v8i){(int)lo.x, (int)lo.y, (int)lo.z, (int)lo.w, (int)hi.x, (int)hi.y, (int)hi.z, (int)hi.w}; }
__device__ __forceinline__ v2u cvt8(v4u x, float s) { v2u o; o.x = pk4(bflo(x.x) * s, bfhi(x.x) * s, bflo(x.y) * s, bfhi(x.y) * s); o.y = pk4(bflo(x.z) * s, bfhi(x.z) * s, bflo(x.w) * s, bfhi(x.w) * s); return o; }
template <int VAR> __device__ __forceinline__ void attn_unit(int h, int qb, const bf16* __restrict__ Q, const unsigned char* __restrict__ Kg, const unsigned char* __restrict__ Vg, const float2* __restrict__ rope, bf16* __restrict__ Y, int yld, int ycol0, LAS char* lds) {
    int tid_ = threadIdx.x; asm volatile("" : "+v"(tid_));
    const int tid = tid_, wid = __builtin_amdgcn_readfirstlane(tid >> 6), lane = tid & 63, r32 = lane & 31, hi = lane >> 5;
    const int NT = 4 * (qb + 1);
    const int q0 = qb * 256, qlo = q0 + wid * 32, qm = qlo + r32 - 4 * hi;
    LAS float* wsf = (LAS float*)(lds + OFF_WS) + wid * 64; LAS float* li_l = wsf; LAS float* al_l = wsf + 32;
    const int kdst = (tid >> 3) * KROW + (tid & 7) * 24, ksrc = (tid >> 3) * QLD + (tid & 7) * 24;
    const int kg = (lane & 7) + 8 * (wid & 1), cg = (lane >> 3) + 8 * (wid >> 1), k5 = (4 * kg) & 31;
    const int vdst = (4 * cg) * VROW + 32 * ((k5 >> 2) & 1) + 16 * ((4 * kg) >> 5) + 4 * (k5 >> 3), vsrc = (4 * kg) * VLD + 4 * cg;
    const unsigned char* Kh = Kg + h * QKD; const unsigned char* Vh = Vg + h * HV;
    v2u stK[3]; unsigned stV[4];
#define K_LOAD(t) do { const size_t kb_ = (size_t)(t) * 64 * QLD; _Pragma("unroll") for (int j = 0; j < 3; ++j) stK[j] = *(const GAS v2u*)(Kh + kb_ + ksrc + 8 * j); } while (0)
#define V_LOAD(t) do { const size_t vb_ = (size_t)(t) * 64 * VLD; _Pragma("unroll") for (int i = 0; i < 4; ++i) stV[i] = *(const GAS unsigned*)(Vh + vb_ + vsrc + i * VLD); } while (0)
#define VT4(j) __builtin_amdgcn_perm(__builtin_amdgcn_perm(stV[3], stV[2], (4u + (j)) << 8 | (j)), __builtin_amdgcn_perm(stV[1], stV[0], (4u + (j)) << 8 | (j)), 0x05040100u)
#define K_WRITE(b3) do { _Pragma("unroll") for (int j = 0; j < 3; ++j) *(LAS v2u*)(lds + OFF_K + (b3) * SHM_K + kdst + 8 * j) = stK[j]; } while (0)
#define V_WRITE(bf) do { LAS char* vp_ = lds + OFF_V + (bf) * SHM_V + vdst; \
          *(LAS unsigned*)(vp_) = VT4(0u); *(LAS unsigned*)(vp_ + VROW) = VT4(1u); *(LAS unsigned*)(vp_ + 2 * VROW) = VT4(2u); *(LAS unsigned*)(vp_ + 3 * VROW) = VT4(3u); } while (0)
#define K_FRAGS(b3) do { const LAS char* kb = kbase + (b3) * SHM_K; _Pragma("unroll") for (int s = 0; s < 3; ++s) { kf[2 * s] = ld32(kb + 64 * s); kf[2 * s + 1] = ld32(kb + 32 * KROW + 64 * s); } } while (0)
    K_LOAD(0); V_LOAD(0);
    v8i qf[3];
    { const bf16* qp = Q + (size_t)(qlo + r32) * QLD + h * QKD;
#pragma unroll
      for (int s = 0; s < 2; ++s) { unsigned w[8];
#pragma unroll
          for (int j = 0; j < 4; ++j) { const v2u c = cvt8(*(const GAS v4u*)(qp + 64 * s + 32 * hi + 8 * j), 64.f); w[2 * j] = c.x; w[2 * j + 1] = c.y; }
          qf[s] = (v8i){(int)w[0], (int)w[1], (int)w[2], (int)w[3], (int)w[4], (int)w[5], (int)w[6], (int)w[7]}; }
      const float2* cs = rope + (size_t)(qlo + r32) * 32 + 16 * hi; unsigned w1[4], w2[4];
#pragma unroll
      for (int j = 0; j < 2; ++j) { const v4u a = *(const GAS v4u*)(qp + 128 + 16 * hi + 8 * j), b = *(const GAS v4u*)(qp + 160 + 16 * hi + 8 * j);
          const unsigned aw[4] = {a.x, a.y, a.z, a.w}, bw[4] = {b.x, b.y, b.z, b.w}; float y1[8], y2[8];
#pragma unroll
          for (int e = 0; e < 4; ++e) { const f32x4 c2 = *(const GAS f32x4*)(cs + 8 * j + 2 * e);
              const float l1 = bflo(aw[e]), h1 = bfhi(aw[e]), l2 = bflo(bw[e]), h2 = bfhi(bw[e]);
              y1[2 * e] = (l1 * c2.x - l2 * c2.y) * 64.f; y1[2 * e + 1] = (h1 * c2.z - h2 * c2.w) * 64.f; y2[2 * e] = (l1 * c2.y + l2 * c2.x) * 64.f; y2[2 * e + 1] = (h1 * c2.w + h2 * c2.z) * 64.f; }
          w1[2 * j] = pk4(y1[0], y1[1], y1[2], y1[3]); w1[2 * j + 1] = pk4(y1[4], y1[5], y1[6], y1[7]); w2[2 * j] = pk4(y2[0], y2[1], y2[2], y2[3]); w2[2 * j + 1] = pk4(y2[4], y2[5], y2[6], y2[7]); }
      qf[2] = (v8i){(int)w1[0], (int)w1[1], (int)w1[2], (int)w1[3], (int)w2[0], (int)w2[1], (int)w2[2], (int)w2[3]}; }
    { v2u k1_[3]; unsigned v1_[4];
#pragma unroll
      for (int j = 0; j < 3; ++j) k1_[j] = *(const GAS v2u*)(Kh + (size_t)64 * QLD + ksrc + 8 * j);
#pragma unroll
      for (int i = 0; i < 4; ++i) v1_[i] = *(const GAS unsigned*)(Vh + (size_t)64 * VLD + vsrc + i * VLD);
      VM_WAIT(); K_WRITE(0); V_WRITE(0);
#pragma unroll
      for (int j = 0; j < 3; ++j) stK[j] = k1_[j];
#pragma unroll
      for (int i = 0; i < 4; ++i) stV[i] = v1_[i];
      K_WRITE(1); V_WRITE(1); }
    __syncthreads();
    float m_reg = 0.f, l_reg = 0.f; f32x16 o[4];
    { float z_ = 0.f; asm volatile("" : "+v"(z_));
#pragma unroll
      for (int d_ = 0; d_ < 4; ++d_)
#pragma unroll
          for (int r = 0; r < 16; ++r) o[d_][r] = z_; }
    const LAS char* kbase = lds + OFF_K + r32 * KROW + 32 * hi;
    const LAS char* vbase = lds + OFF_V + r32 * VROW + 32 * hi;
    for (int t = 0; t < NT; ++t) {
        if (t + 2 < NT) { K_LOAD(t + 2); V_LOAD(t + 2); }
        f32x16 p0, p1;
        const bool live = t * 64 <= qlo + 31;
        if (live) {
        { float z_ = POFF - m_reg; asm volatile("" : "+v"(z_));
#pragma unroll
          for (int r = 0; r < 16; ++r) { p0[r] = z_; p1[r] = z_; } }
        { v8i kf[6]; K_FRAGS(t & 3);
          __builtin_amdgcn_sched_barrier(0);
#pragma unroll
          for (int s = 0; s < 3; ++s) { p0 = mfma8(kf[2 * s], qf[s], p0, SC_K, SC_Q); p1 = mfma8(kf[2 * s + 1], qf[s], p1, SC_K, SC_Q); } }
        }
        v8i vf[4];
        if (live) { const LAS char* vb = vbase + (t & 3) * SHM_V;
#pragma unroll
          for (int db = 0; db < 4; ++db) vf[db] = ld32(vb + 32 * db * VROW);
          __builtin_amdgcn_sched_barrier(0); }
        if (live) {
        { const int kb_ = t * 64; if (kb_ + 63 > qlo) { asm volatile("" ::: "memory"); at::mask_tile(p0, p1, qm - kb_); } }
        float pmax = p0[0];
#pragma unroll
        for (int r = 1; r < 16; ++r) pmax = fmaxf(pmax, p0[r]);
#pragma unroll
        for (int r = 0; r < 16; ++r) pmax = fmaxf(pmax, p1[r]);
        { auto rr = __builtin_amdgcn_permlane32_swap(__float_as_uint(pmax), __float_as_uint(pmax), false, false); pmax = fmaxf(__uint_as_float(rr[0]), __uint_as_float(rr[1])); }
        float alpha = 1.f;
        if (!__all(pmax <= THR + POFF)) {
            const float dm = fmaxf(pmax - POFF, 0.f); alpha = __builtin_amdgcn_exp2f(-dm); m_reg += dm;
#pragma unroll
            for (int r = 0; r < 16; ++r) { p0[r] -= dm; p1[r] -= dm; } }
#pragma unroll
        for (int r = 0; r < 16; ++r) { p0[r] = __builtin_amdgcn_exp2f(p0[r]); p1[r] = __builtin_amdgcn_exp2f(p1[r]); }
        typedef float f32x2v __attribute__((ext_vector_type(2)));
        f32x2v s2 = (f32x2v){p0[0], p0[1]} + (f32x2v){p1[0], p1[1]};
#pragma unroll
        for (int r = 2; r < 16; r += 2) s2 += (f32x2v){p0[r], p0[r + 1]} + (f32x2v){p1[r], p1[r + 1]};
        float ps = s2.x + s2.y;
        { auto rr = __builtin_amdgcn_permlane32_swap(__float_as_uint(ps), __float_as_uint(ps), false, false); ps = __uint_as_float(rr[0]) + __uint_as_float(rr[1]); }
        l_reg = l_reg * alpha + ps;
        const v8i pf = (v8i){(int)pk4(p0[0], p0[1], p0[2], p0[3]), (int)pk4(p0[4], p0[5], p0[6], p0[7]), (int)pk4(p0[8], p0[9], p0[10], p0[11]), (int)pk4(p0[12], p0[13], p0[14], p0[15]),
                             (int)pk4(p1[0], p1[1], p1[2], p1[3]), (int)pk4(p1[4], p1[5], p1[6], p1[7]), (int)pk4(p1[8], p1[9], p1[10], p1[11]), (int)pk4(p1[12], p1[13], p1[14], p1[15])};
        if (__any(alpha < 1.f)) { if (hi == 0) al_l[r32] = alpha; LDS_WAIT();
#pragma unroll
            for (int d_ = 0; d_ < 4; ++d_)
#pragma unroll
                for (int r = 0; r < 16; ++r) o[d_][r] *= al_l[at::crow(r, hi)]; }
        {
#pragma unroll
          for (int db = 0; db < 4; ++db) o[db] = mfma8(pf, vf[db], o[db], SC_1, SC_V); }
        }
        if (t + 2 < NT) { VM_WAIT(); K_WRITE((t + 2) & 3); V_WRITE((t + 2) & 3); }
        if (t & 1) __syncthreads();
    }
#undef K_LOAD
#undef V_LOAD
#undef K_WRITE
#undef V_WRITE
#undef K_FRAGS
#undef VT4
    if (hi == 0) li_l[r32] = l_reg; LDS_WAIT();
    bf16* Yw = Y + (size_t)qlo * yld + ycol0 + h * HV;
#pragma unroll
    for (int r = 0; r < 16; ++r) { const int orow = at::crow(r, hi); const float il = 1.f / li_l[orow];
#pragma unroll
        for (int d0 = 0; d0 < 4; ++d0) { const float v = o[d0][r] * il; const float vn = __shfl_xor(v, 1);
            if ((r32 & 1) == 0) *(GAS unsigned*)(Yw + (size_t)orow * yld + d0 * 32 + r32) = at::cvtpk(v, vn); } }
    __syncthreads();
}
}
namespace s5 {
constexpr int G = 32, P = 64, C = 16, T = 64, NCH = M / T;
struct Par { const float *a_re, *a_im, *b_re, *b_im, *c_re, *c_im, *d, *log_dt; };
__device__ __forceinline__ void lam_of(const Par& q, int g, int p, float& lr, float& li, float& dt) { lr = fminf(q.a_re[g * P + p], -1e-4f); li = q.a_im[g * P + p]; dt = expf(q.log_dt[g]); }
__device__ __forceinline__ float2 cmul(float2 a, float2 b) { return make_float2(a.x * b.x - a.y * b.y, a.x * b.y + a.y * b.x); }
__device__ __forceinline__ float2 lam_pow(float lr, float li, float dt, float k) { const float e = expf(lr * dt * k); float sn, cs; sincosf(li * dt * k, &sn, &cs); return make_float2(e * cs, e * sn); }
__device__ __forceinline__ float2 coef_of(float lr, float li, float dt) { const float2 lb = lam_pow(lr, li, dt, 1.f); const float nr = lb.x - 1.f, ni = lb.y, den = lr * lr + li * li; return make_float2((nr * lr + ni * li) / den, (ni * lr - nr * li) / den); }
__device__ __forceinline__ void gen_kc(Frame& F, const Par& q, float* __restrict__ Kc) {
    const int nth = F.NGW * 64;
    for (int i = opq_s(F.gw) * 64 + (opq((int)threadIdx.x) & 63); i < G * T * C; i += nth) {
        const int c = i & 15, lag = (i >> 4) & 63, g = i >> 10;
        float acc[16];
#pragma unroll
        for (int j = 0; j < 16; ++j) acc[j] = 0.f;
        for (int p = 0; p < P; ++p) {
            float lr, li, dt; lam_of(q, g, p, lr, li, dt);
            const float2 w = cmul(cmul(make_float2(q.c_re[(g * C + c) * P + p], q.c_im[(g * C + c) * P + p]), lam_pow(lr, li, dt, (float)lag)), coef_of(lr, li, dt));
            const float* br = q.b_re + (size_t)(g * P + p) * C; const float* bi = q.b_im + (size_t)(g * P + p) * C;
#pragma unroll
            for (int j = 0; j < 16; ++j) acc[j] += w.x * br[j] - w.y * bi[j];
        }
        if (lag == 0) acc[c] += q.d[g * C + c];
        float* o = Kc + (size_t)i * 16;
#pragma unroll
        for (int j = 0; j < 16; j += 4) *(GAS f32x4*)(o + j) = (f32x4){acc[j], acc[j + 1], acc[j + 2], acc[j + 3]};
    }
}
__device__ __forceinline__ void gen_pw(Frame& F, const Par& q, float2* __restrict__ PW) {
    const int nth = F.NGW * 64;
    for (int i = opq_s(F.gw) * 64 + (opq((int)threadIdx.x) & 63); i < G * P * 66; i += nth) {
        const int k = i % 66, gp = i / 66, p = gp & 63, g = gp >> 6; float lr, li, dt; lam_of(q, g, p, lr, li, dt);
        PW[i] = (k == 65) ? coef_of(lr, li, dt) : lam_pow(lr, li, dt, (float)k);
    }
}
__device__ __forceinline__ void gen_mats(Frame& F, const Par& q, const float* __restrict__ Kc, const float2* __restrict__ PW, bf16* __restrict__ Kmat, bf16* __restrict__ Hmat) {
    const int nth = F.NGW * 64, t0 = opq_s(F.gw) * 64 + (opq((int)threadIdx.x) & 63);
    for (int i = t0; i < G * 1024 * 144; i += nth) {
        const int kc = i % 144, n = (i / 144) & 1023, g = i / (144 * 1024), t = n >> 4, c = n & 15;
        v4u o = {0u, 0u, 0u, 0u};
        if (kc < 128) { const int s = kc >> 1, c0 = (kc & 1) * 8;
            if (t >= s) { const float* kp = Kc + ((size_t)(g * T + (t - s)) * C + c) * 16 + c0; const f32x4 a = *(const GAS f32x4*)kp, b = *(const GAS f32x4*)(kp + 4);
                o.x = pk2(a.x, a.y); o.y = pk2(a.z, a.w); o.z = pk2(b.x, b.y); o.w = pk2(b.z, b.w); } }
        else { const int p0 = (kc - 128) * 4; unsigned w[4];
#pragma unroll
            for (int j = 0; j < 4; ++j) { const int p = p0 + j;
                const float2 v = cmul(make_float2(q.c_re[(g * C + c) * P + p], q.c_im[(g * C + c) * P + p]), PW[(size_t)(g * P + p) * 66 + t + 1]); w[j] = pk2(v.x, -v.y); }
            o.x = w[0]; o.y = w[1]; o.z = w[2]; o.w = w[3]; }
        *(GAS v4u*)(Kmat + ((size_t)(g * 1024 + n) * 1152 + kc * 8)) = o;
    }
    for (int i = t0; i < G * 256 * 128; i += nth) {
        const int kc = i & 127, n = (i >> 7) & 255, g = i >> 15;
        v4u o = {0u, 0u, 0u, 0u};
        if (n < 128) { const int p = n >> 1, r = n & 1, s = kc >> 1, c0 = (kc & 1) * 8;
            const float2 w = cmul(PW[(size_t)(g * P + p) * 66 + 63 - s], PW[(size_t)(g * P + p) * 66 + 65]);
            const float* br = q.b_re + (size_t)(g * P + p) * C + c0; const float* bi = q.b_im + (size_t)(g * P + p) * C + c0; float v[8];
#pragma unroll
            for (int j = 0; j < 8; ++j) v[j] = r ? (w.x * bi[j] + w.y * br[j]) : (w.x * br[j] - w.y * bi[j]);
            o.x = pk2(v[0], v[1]); o.y = pk2(v[2], v[3]); o.z = pk2(v[4], v[5]); o.w = pk2(v[6], v[7]); }
        *(GAS v4u*)(Hmat + ((size_t)(g * 256 + n) * 1024 + kc * 8)) = o;
    }
}
struct OrderE { int G_, c;
    __device__ bool next(int i, pg8::Unit& u) const { const int L_ = i * G_ + c; if (L_ >= G) return false; u.pm = L_; u.pn = 0; u.pa = L_; u.pb = L_; return true; }
    __device__ __forceinline__ void a_ready(const pg8::Unit&) const {} __device__ __forceinline__ void done(const pg8::Unit&) const {} };
struct OrderY { int G_, c;
    __device__ bool next(int i, pg8::Unit& u) const { const int L_ = i * G_ + c; if (L_ >= G * 4) return false; u.pm = L_ >> 2; u.pn = L_ & 3; u.pa = u.pm; u.pb = L_; return true; }
    __device__ __forceinline__ void a_ready(const pg8::Unit&) const {} __device__ __forceinline__ void done(const pg8::Unit&) const {} };
struct EpiE {
    static constexpr bool PERM = false, AFTER_DRAIN = false;
    float* E;
    __device__ __forceinline__ void operator()(const pg8::f32x4 (&acc)[2][2][4][2], const pg8::Unit& u, int wr, int wc, int fr, int fq) const {
        { const int ln_ = opq((int)threadIdx.x) & 63; fr = ln_ & 15; fq = ln_ >> 4; }
#pragma unroll
        for (int ai = 0; ai < 2; ++ai)
#pragma unroll
            for (int m = 0; m < 4; ++m) { const int row = u.pm * 256 + ai * 128 + wr * 64 + m * 16 + fr;
#pragma unroll
                for (int n = 0; n < 2; ++n) *(GAS pg8::f32x4*)(E + (size_t)row * 128 + wc * 32 + n * 16 + 4 * fq) = acc[ai][0][m][n]; }
    }
};
__device__ __forceinline__ float gelu_t(float x) { const float u2 = 1.5957691216057308f * (x + 0.044715f * x * x * x); return x * __builtin_amdgcn_rcpf(1.f + __expf(-u2)); }
struct EpiY {
    static constexpr bool PERM = true, AFTER_DRAIN = false;
    bf16* YG;
    __device__ __forceinline__ void operator()(const pg8::f32x4 (&acc)[2][2][4][2], const pg8::Unit& u, int wr, int wc, int fr, int fq) const {
        { const int ln_ = opq((int)threadIdx.x) & 63; fr = ln_ & 15; fq = ln_ >> 4; }
#pragma unroll
        for (int ai = 0; ai < 2; ++ai)
#pragma unroll
            for (int m = 0; m < 4; ++m) { const int chunk = ai * 128 + wr * 64 + m * 16 + fr;
#pragma unroll
                for (int bj = 0; bj < 2; ++bj) { const int n0 = u.pn * 256 + bj * 128 + wc * 32 + 8 * fq, t = n0 >> 4, c0 = n0 & 15;
                    const pg8::f32x4 v0 = acc[ai][bj][m][0], v1 = acc[ai][bj][m][1];
                    v4u w; w.x = pg8::cvt_pk_bf16(gelu_t(v0[0]), gelu_t(v0[1])); w.y = pg8::cvt_pk_bf16(gelu_t(v0[2]), gelu_t(v0[3]));
                    w.z = pg8::cvt_pk_bf16(gelu_t(v1[0]), gelu_t(v1[1])); w.w = pg8::cvt_pk_bf16(gelu_t(v1[2]), gelu_t(v1[3]));
                    *(GAS v4u*)(YG + (size_t)(chunk * 64 + t) * 512 + u.pm * 16 + c0) = w; } }
    }
};
struct EpiGlu {
    static constexpr bool PERM = true, AFTER_DRAIN = false;
    const bf16* YG; const float* bias; bf16* Y;
    __device__ __forceinline__ void operator()(const pg8::f32x4 (&acc)[2][2][4][2], const pg8::Unit& u, int wr, int wc, int fr, int fq) const {
        { const int ln_ = opq((int)threadIdx.x) & 63; fr = ln_ & 15; fq = ln_ >> 4; }
#pragma unroll
        for (int bj = 0; bj < 2; ++bj) { const int col = u.pn * 256 + bj * 128 + wc * 32 + 8 * fq;
            const f32x4 b0 = *(const GAS f32x4*)(bias + col), b1 = *(const GAS f32x4*)(bias + col + 4);
#pragma unroll
            for (int ai = 0; ai < 2; ++ai)
#pragma unroll
                for (int m = 0; m < 4; ++m) { const int row = u.pm * 256 + ai * 128 + wr * 64 + m * 16 + fr;
                    const v4u yv = *(const GAS v4u*)(YG + (size_t)row * 512 + col);
                    const pg8::f32x4 z0 = acc[ai][bj][m][0], z1 = acc[ai][bj][m][1];
                    v4u w; w.x = pg8::cvt_pk_bf16(bflo(yv.x) * sigmoidf_(z0[0] + b0.x), bfhi(yv.x) * sigmoidf_(z0[1] + b0.y)); w.y = pg8::cvt_pk_bf16(bflo(yv.y) * sigmoidf_(z0[2] + b0.z), bfhi(yv.y) * sigmoidf_(z0[3] + b0.w));
                    w.z = pg8::cvt_pk_bf16(bflo(yv.z) * sigmoidf_(z1[0] + b1.x), bfhi(yv.z) * sigmoidf_(z1[1] + b1.y)); w.w = pg8::cvt_pk_bf16(bflo(yv.w) * sigmoidf_(z1[2] + b1.z), bfhi(yv.w) * sigmoidf_(z1[3] + b1.w));
                    *(GAS v4u*)(Y + (size_t)row * D + col) = w; asm volatile("" ::: "memory"); } }
    }
};
__device__ __forceinline__ void carry(Frame& F, int wave0, const Par& q, const float* __restrict__ E, bf16* __restrict__ U2) {
    const int lane = (opq((int)threadIdx.x) & 63);
    const int gwr = opq_s(F.gw) - wave0; if (gwr < 0 || gwr >= 4 * G) return;
    const int g = gwr >> 2, seg = gwr & 3;
    float lr, li, dt; lam_of(q, g, lane, lr, li, dt);
    const float2 a = lam_pow(lr, li, dt, 64.f), A = lam_pow(lr, li, dt, 4096.f);
    const float2* Eg = (const float2*)(E + (size_t)g * 256 * 128) + lane + (size_t)(64 * seg) * 64; unsigned* Ug = (unsigned*)(U2 + (size_t)g * 256 * 1152 + 1024) + lane + (size_t)(64 * seg) * 576;
    float sr = 0.f, si = 0.f;
    for (int c0 = 0; c0 < 64; c0 += 32) {
        float2 e[32];
#pragma unroll
        for (int j = 0; j < 32; ++j) e[j] = Eg[(size_t)(c0 + j) * 64];
#pragma unroll
        for (int j = 0; j < 32; ++j) { const float nr = a.x * sr - a.y * si + e[j].x, ni = a.x * si + a.y * sr + e[j].y; sr = nr; si = ni; }
    }
    LAS float* ex = (LAS float*)F.lds + ((opq_s(F.wave) >> 2) * 4) * 128;
    ex[(seg * 64 + lane) * 2] = sr; ex[(seg * 64 + lane) * 2 + 1] = si;
    __syncthreads();
    sr = 0.f; si = 0.f;
    for (int k = 0; k < seg; ++k) { const float er = ex[(k * 64 + lane) * 2], ei = ex[(k * 64 + lane) * 2 + 1]; const float nr = A.x * sr - A.y * si + er, ni = A.x * si + A.y * sr + ei; sr = nr; si = ni; }
    for (int c0 = 0; c0 < 64; c0 += 32) {
        float2 e[32];
#pragma unroll
        for (int j = 0; j < 32; ++j) e[j] = Eg[(size_t)(c0 + j) * 64];
#pragma unroll
        for (int j = 0; j < 32; ++j) { Ug[(size_t)(c0 + j) * 576] = pk2(sr, si); const float nr = a.x * sr - a.y * si + e[j].x, ni = a.x * si + a.y * sr + e[j].y; sr = nr; si = ni; }
    }
    __syncthreads();
}
}
namespace hg {
constexpr int B_OFF = 0, BSTR = 129;
constexpr int QT_OFF = 33024, QI_OFF = 50432, KI_OFF = 67840, VT_OFF = 111360;
constexpr int KT_OFF = 33024, VSA_OFF = 51456;
constexpr int RS_OFF = 129792;
constexpr int R128 = 272, R64 = 144;
__device__ __forceinline__ pg8::f32x4 mfma16(bf16x8 a, bf16x8 b, pg8::f32x4 c) { return __builtin_amdgcn_mfma_f32_16x16x32_bf16(a, b, c, 0, 0, 0); }
__device__ __forceinline__ void cum_logf_r(const v4u z0, const v4u z1, const float* __restrict__ lb, int h, LAS unsigned char* lds, int tid) {
    LAS float* B = (LAS float*)(lds + B_OFF);
    const int t = tid >> 3, d0 = (tid & 7) * 16;
    { const unsigned zw[8] = {z0.x, z0.y, z0.z, z0.w, z1.x, z1.y, z1.z, z1.w};
#pragma unroll
      for (int j = 0; j < 8; ++j) { const float l0 = lb[h * 128 + d0 + 2 * j], l1 = lb[h * 128 + d0 + 2 * j + 1];
          B[t * BSTR + d0 + 2 * j] = __logf(l0 + (1.f - l0) * sigmoidf_(bflo(zw[j]))); B[t * BSTR + d0 + 2 * j + 1] = __logf(l1 + (1.f - l1) * sigmoidf_(bfhi(zw[j]))); } }
    __syncthreads();
    const int d = tid & 127, qtr = tid >> 7;
    { float run = 0.f;
#pragma unroll
      for (int i = 0; i < 16; ++i) { run += B[(16 * qtr + i) * BSTR + d]; B[(16 * qtr + i) * BSTR + d] = run; } }
    __syncthreads();
    float offs = 0.f;
    for (int q2 = 0; q2 < qtr; ++q2) offs += B[(16 * q2 + 15) * BSTR + d];
    __syncthreads();
#pragma unroll
    for (int i = 0; i < 16; ++i) B[(16 * qtr + i) * BSTR + d] += offs;
    __syncthreads();
}
__device__ __forceinline__ void cum_logf(const bf16* __restrict__ P, const float* __restrict__ lb, int t0, int h, LAS unsigned char* lds, int tid) {
    const int t = tid >> 3, d0 = (tid & 7) * 16; const bf16* zp = P + (size_t)(t0 + t) * NPROJ + P_HF + h * 128 + d0;
    const v4u z0 = *(const GAS v4u*)zp, z1 = *(const GAS v4u*)(zp + 8); cum_logf_r(z0, z1, lb, h, lds, tid);
}
__device__ __forceinline__ void stage_vt_r(const v4u v0, const v4u v1, LAS unsigned char* lds, int vs_off, int tid);
__device__ __forceinline__ void stage_vt(const bf16* __restrict__ P, int t0, int h, LAS unsigned char* lds, int vs_off, int tid) {
    const int t = tid >> 3, e0 = (tid & 7) * 16; const bf16* vp = P + (size_t)(t0 + t) * NPROJ + P_HI + h * 128 + e0;
    const v4u v0 = *(const GAS v4u*)vp, v1 = *(const GAS v4u*)(vp + 8); stage_vt_r(v0, v1, lds, vs_off, tid);
}
__device__ __forceinline__ void stage_vt_r(const v4u v0, const v4u v1, LAS unsigned char* lds, int vs_off, int tid) {
    { const int t = tid >> 3, e0 = (tid & 7) * 16;
      *(LAS v4u*)(lds + vs_off + t * R128 + e0 * 2) = v0; *(LAS v4u*)(lds + vs_off + t * R128 + e0 * 2 + 16) = v1; }
    __syncthreads();
#pragma unroll
    for (int it = 0; it < 2; ++it) { const int id = tid + 512 * it, e = id & 127, s0 = (id >> 7) * 8;
        unsigned short v[8];
#pragma unroll
        for (int j = 0; j < 8; ++j) v[j] = *(const LAS unsigned short*)(lds + vs_off + (s0 + j) * R128 + e * 2);
        v4u o; o.x = v[0] | ((unsigned)v[1] << 16); o.y = v[2] | ((unsigned)v[3] << 16); o.z = v[4] | ((unsigned)v[5] << 16); o.w = v[6] | ((unsigned)v[7] << 16);
        *(LAS v4u*)(lds + VT_OFF + e * R64 + s0 * 2) = o; }
    __syncthreads();
}
__device__ __forceinline__ void unit_a(int unit, const bf16* __restrict__ P, const float* __restrict__ lb, float* __restrict__ UT, float* __restrict__ Gv, LAS unsigned char* lds) {
    const int tid = opq((int)threadIdx.x), wid = __builtin_amdgcn_readfirstlane(tid >> 6), lane = tid & 63, r = lane & 15, q = lane >> 4;
    const int c = unit >> 2, h = unit & 3, t0 = c * 64;
    cum_logf(P, lb, t0, h, lds, tid);
    LAS float* B = (LAS float*)(lds + B_OFF);
    { const int t = tid >> 3, d0 = (tid & 7) * 16; const bf16* zp = P + (size_t)(t0 + t) * NPROJ + P_HF + h * 128 + d0; const v4u z0 = *(const GAS v4u*)zp, z1 = *(const GAS v4u*)(zp + 8);
      const unsigned zw[8] = {z0.x, z0.y, z0.z, z0.w, z1.x, z1.y, z1.z, z1.w};
#pragma unroll
      for (int j = 0; j < 16; ++j) { const int d = d0 + j; const float z = (j & 1) ? bfhi(zw[j >> 1]) : bflo(zw[j >> 1]); const float l = lb[h * 128 + d];
          const float kt = (1.f - l) * sigmoidf_(-z) * __expf(B[63 * BSTR + d] - B[t * BSTR + d]);
          *(LAS unsigned short*)(lds + KT_OFF + d * R64 + t * 2) = (unsigned short)f2bf(kt); } }
    if (tid < 128) Gv[(size_t)unit * 128 + tid] = __expf(B[63 * BSTR + tid]);
    stage_vt(P, t0, h, lds, VSA_OFF, tid);
    bf16x8 a[2];
#pragma unroll
    for (int ks = 0; ks < 2; ++ks) a[ks] = *(const LAS bf16x8*)(lds + VT_OFF + (16 * wid + r) * R64 + (32 * ks + 8 * q) * 2);
    float* Uo = UT + (size_t)unit * 16384;
#pragma unroll
    for (int nt = 0; nt < 8; ++nt) { pg8::f32x4 c4 = {0.f, 0.f, 0.f, 0.f};
#pragma unroll
        for (int ks = 0; ks < 2; ++ks) { const bf16x8 b = *(const LAS bf16x8*)(lds + KT_OFF + (16 * nt + r) * R64 + (32 * ks + 8 * q) * 2); c4 = mfma16(a[ks], b, c4); }
#pragma unroll
        for (int j = 0; j < 4; ++j) Uo[(16 * wid + 4 * q + j) * 128 + 16 * nt + r] = c4[j]; }
    __syncthreads();
}
__device__ __forceinline__ void scan_b(Frame& F, int wave0, const float* __restrict__ UT, const float* __restrict__ Gv, bf16* __restrict__ ST) {
    const int gwr = opq_s(F.gw) - wave0;
    if (gwr < 0 || gwr >= 512) return;
    { const int i = gwr * 64 + (opq((int)threadIdx.x) & 63);
        const int dp = i & 63, e = (i >> 6) & 127, h = i >> 13;
        float s0 = 0.f, s1 = 0.f;
        const float2* up = (const float2*)UT + ((size_t)h * 16384 + e * 128) / 2 + dp; const float2* gp = (const float2*)Gv + (size_t)h * 64 + dp;
        unsigned* sp = (unsigned*)ST + ((size_t)h * 16384 + e * 128) / 2 + dp;
        for (int c0 = 0; c0 < 256; c0 += 32) {
            float2 u[32], g[32];
#pragma unroll
            for (int j = 0; j < 32; ++j) { u[j] = up[(size_t)(c0 + j) * 32768]; g[j] = gp[(size_t)(c0 + j) * 256]; }
#pragma unroll
            for (int j = 0; j < 32; ++j) { sp[(size_t)(c0 + j) * 32768] = pk2(s0, s1); s0 = g[j].x * s0 + u[j].x; s1 = g[j].y * s1 + u[j].y; }
        }
    }
}
__device__ __forceinline__ void unit_c(int unit, const bf16* __restrict__ P, const float* __restrict__ lb, const bf16* __restrict__ ST, const float* __restrict__ onorm, bf16* __restrict__ Y, LAS unsigned char* lds) {
    const int tid = opq((int)threadIdx.x), wid = __builtin_amdgcn_readfirstlane(tid >> 6), lane = tid & 63, r = lane & 15, q = lane >> 4;
    const int c = unit >> 2, h = unit & 3, t0 = c * 64;
    v4u z0, z1, q0, q1, vv0, vv1;
    { const int t = tid >> 3, d0 = (tid & 7) * 16; const bf16* rp = P + (size_t)(t0 + t) * NPROJ + h * 128 + d0;
      z0 = *(const GAS v4u*)(rp + P_HF); z1 = *(const GAS v4u*)(rp + P_HF + 8); q0 = *(const GAS v4u*)(rp + P_HQ); q1 = *(const GAS v4u*)(rp + P_HQ + 8); vv0 = *(const GAS v4u*)(rp + P_HI); vv1 = *(const GAS v4u*)(rp + P_HI + 8); }
    bf16x8 sfr[4][4]; unsigned short gt[4][4];
    { const int mt_ = wid & 3, nh_ = wid >> 2; const bf16* Sg_ = ST + (size_t)unit * 16384;
#pragma unroll
      for (int ks = 0; ks < 4; ++ks)
#pragma unroll
          for (int n = 0; n < 4; ++n) sfr[ks][n] = *(const GAS bf16x8*)(Sg_ + (size_t)(16 * (4 * nh_ + n) + r) * 128 + 32 * ks + 8 * q);
#pragma unroll
      for (int j = 0; j < 4; ++j) { const bf16* gp_ = P + (size_t)(t0 + 16 * mt_ + 4 * q + j) * NPROJ + P_HG + h * 128;
#pragma unroll
          for (int n = 0; n < 4; ++n) gt[j][n] = gp_[16 * (4 * nh_ + n) + r]; } }
    cum_logf_r(z0, z1, lb, h, lds, tid);
    stage_vt_r(vv0, vv1, lds, KI_OFF, tid);
    LAS float* B = (LAS float*)(lds + B_OFF);
    { const int t = tid >> 3, d0 = (tid & 7) * 16, ti = t >> 4;
      const unsigned zw[8] = {z0.x, z0.y, z0.z, z0.w, z1.x, z1.y, z1.z, z1.w}, qw[8] = {q0.x, q0.y, q0.z, q0.w, q1.x, q1.y, q1.z, q1.w};
      float qv[16], kv[16], bt[16];
#pragma unroll
      for (int j = 0; j < 16; ++j) { const float z = (j & 1) ? bfhi(zw[j >> 1]) : bflo(zw[j >> 1]), qq = (j & 1) ? bfhi(qw[j >> 1]) : bflo(qw[j >> 1]); const float l = lb[h * 128 + d0 + j];
          qv[j] = siluf_(qq); kv[j] = (1.f - l) * sigmoidf_(-z); bt[j] = B[t * BSTR + d0 + j]; }
      unsigned w[8];
#pragma unroll
      for (int j = 0; j < 8; ++j) w[j] = pk2(qv[2 * j] * __expf(bt[2 * j]), qv[2 * j + 1] * __expf(bt[2 * j + 1]));
      *(LAS v4u*)(lds + QT_OFF + t * R128 + d0 * 2) = (v4u){w[0], w[1], w[2], w[3]}; *(LAS v4u*)(lds + QT_OFF + t * R128 + d0 * 2 + 16) = (v4u){w[4], w[5], w[6], w[7]};
#pragma unroll
      for (int i = 0; i < 4; ++i) {
          if (i >= ti) {
              float be[16];
#pragma unroll
              for (int j = 0; j < 16; ++j) be[j] = i ? B[(16 * i - 1) * BSTR + d0 + j] : 0.f;
#pragma unroll
              for (int j = 0; j < 8; ++j) w[j] = pk2(kv[2 * j] * __expf(fminf(be[2 * j] - bt[2 * j], 80.f)), kv[2 * j + 1] * __expf(fminf(be[2 * j + 1] - bt[2 * j + 1], 80.f)));
              const int row = 8 * i * (i + 1) + t;
              *(LAS v4u*)(lds + KI_OFF + row * R128 + d0 * 2) = (v4u){w[0], w[1], w[2], w[3]}; *(LAS v4u*)(lds + KI_OFF + row * R128 + d0 * 2 + 16) = (v4u){w[4], w[5], w[6], w[7]};
              if (i == ti) {
#pragma unroll
                  for (int j = 0; j < 8; ++j) w[j] = pk2(qv[2 * j] * __expf(bt[2 * j] - be[2 * j]), qv[2 * j + 1] * __expf(bt[2 * j + 1] - be[2 * j + 1]));
                  *(LAS v4u*)(lds + QI_OFF + t * R128 + d0 * 2) = (v4u){w[0], w[1], w[2], w[3]}; *(LAS v4u*)(lds + QI_OFF + t * R128 + d0 * 2 + 16) = (v4u){w[4], w[5], w[6], w[7]}; }
          } } }
    __syncthreads();
    const int mt = wid & 3, nh = wid >> 2;
    pg8::f32x4 acc[4];
#pragma unroll
    for (int n = 0; n < 4; ++n) acc[n] = (pg8::f32x4){0.f, 0.f, 0.f, 0.f};
    const bf16* Sg = ST + (size_t)unit * 16384;
#if !(defined(HG_DBG) && HG_DBG == 1)
#pragma unroll
    for (int ks = 0; ks < 4; ++ks) { const bf16x8 a = *(const LAS bf16x8*)(lds + QT_OFF + (16 * mt + r) * R128 + (32 * ks + 8 * q) * 2);
#pragma unroll
        for (int n = 0; n < 4; ++n) acc[n] = mfma16(a, sfr[ks][n], acc[n]); }
#endif
    __syncthreads();
#pragma unroll
    for (int k2 = 0; k2 < 2; ++k2) { const int tt = wid + 8 * k2, i = tt >> 2, j = tt & 3;
        pg8::f32x4 c4 = {0.f, 0.f, 0.f, 0.f};
        if (j <= i) {
#pragma unroll
            for (int ks = 0; ks < 4; ++ks) { const bf16x8 a = *(const LAS bf16x8*)(lds + QI_OFF + (16 * i + r) * R128 + (32 * ks + 8 * q) * 2);
                const bf16x8 b = *(const LAS bf16x8*)(lds + KI_OFF + (8 * i * (i + 1) + 16 * j + r) * R128 + (32 * ks + 8 * q) * 2); c4 = mfma16(a, b, c4); } }
#pragma unroll
        for (int jj = 0; jj < 4; ++jj) { const int t = 16 * i + 4 * q + jj, s = 16 * j + r; const float v = (j <= i && s <= t) ? c4[jj] : 0.f;
            *(LAS unsigned short*)(lds + QT_OFF + t * R64 + s * 2) = (unsigned short)f2bf(v); } }
    __syncthreads();
#pragma unroll
    for (int ks = 0; ks < 2; ++ks) { const bf16x8 a = *(const LAS bf16x8*)(lds + QT_OFF + (16 * mt + r) * R64 + (32 * ks + 8 * q) * 2);
#pragma unroll
        for (int n = 0; n < 4; ++n) { const bf16x8 b = *(const LAS bf16x8*)(lds + VT_OFF + (16 * (4 * nh + n) + r) * R64 + (32 * ks + 8 * q) * 2); acc[n] = mfma16(a, b, acc[n]); } }
    LAS float* RS = (LAS float*)(lds + RS_OFF);
    float ss[4];
#pragma unroll
    for (int j = 0; j < 4; ++j) { float s = 0.f;
#pragma unroll
        for (int n = 0; n < 4; ++n) s += acc[n][j] * acc[n][j];
        s += __shfl_xor(s, 1); s += __shfl_xor(s, 2); s += __shfl_xor(s, 4); s += __shfl_xor(s, 8); ss[j] = s; }
    if (r == 0) {
#pragma unroll
        for (int j = 0; j < 4; ++j) RS[(16 * mt + 4 * q + j) * 2 + nh] = ss[j]; }
    __syncthreads();
#pragma unroll
    for (int j = 0; j < 4; ++j) { const int t = 16 * mt + 4 * q + j; const float rstd = rsqrtf((RS[t * 2] + RS[t * 2 + 1]) * (1.f / 128.f) + RMS_EPS);
        const bf16* gp = P + (size_t)(t0 + t) * NPROJ + P_HG + h * 128; bf16* yp = Y + (size_t)(t0 + t) * D + 1536 + h * 128;
#pragma unroll
        for (int n = 0; n < 4; ++n) { const int e = 16 * (4 * nh + n) + r; yp[e] = (unsigned short)f2bf(acc[n][j] * rstd * onorm[e] * siluf_(bf2f(gt[j][n]))); } }
    __syncthreads();
}
}
constexpr int TAIL_RT0 = 128, TAIL_ROWS = 2048, TAIL_KS = 4;
struct EpiRes {
    static constexpr bool PERM = true, AFTER_DRAIN = false;
    const void* xres; bf16* O; int xf32;
    __device__ __forceinline__ void operator()(const pg8::f32x4 (&acc)[2][2][4][2], const pg8::Unit& u, int wr, int wc, int fr, int fq) const {
        { const int ln_ = opq((int)threadIdx.x) & 63; fr = ln_ & 15; fq = ln_ >> 4; }
#pragma unroll
        for (int ai = 0; ai < 2; ++ai) {
            const size_t off0 = (size_t)(u.pm * 256 + ai * 128 + wr * 64 + fr) * D + u.pn * 256 + wc * 32 + 8 * fq;
            if (xf32) {
#pragma unroll
                for (int mh = 0; mh < 2; ++mh) { f32x4 x0[2][2], x1[2][2];
#pragma unroll
                    for (int m2 = 0; m2 < 2; ++m2)
#pragma unroll
                        for (int bj = 0; bj < 2; ++bj) { const float* xp = (const float*)xres + off0 + (size_t)((mh * 2 + m2) * 16) * D + bj * 128; x0[m2][bj] = *(const GAS f32x4*)xp; x1[m2][bj] = *(const GAS f32x4*)(xp + 4); }
#pragma unroll
                    for (int m2 = 0; m2 < 2; ++m2)
#pragma unroll
                        for (int bj = 0; bj < 2; ++bj) { const int m = mh * 2 + m2; const pg8::f32x4 a0 = acc[ai][bj][m][0], a1 = acc[ai][bj][m][1]; const f32x4 p = x0[m2][bj], q = x1[m2][bj];
                            v4u w; w.x = pg8::cvt_pk_bf16(ALPHA * p.x + a0[0], ALPHA * p.y + a0[1]); w.y = pg8::cvt_pk_bf16(ALPHA * p.z + a0[2], ALPHA * p.w + a0[3]);
                            w.z = pg8::cvt_pk_bf16(ALPHA * q.x + a1[0], ALPHA * q.y + a1[1]); w.w = pg8::cvt_pk_bf16(ALPHA * q.z + a1[2], ALPHA * q.w + a1[3]);
                            *(GAS v4u*)(O + off0 + (size_t)(m * 16) * D + bj * 128) = w; }
                    asm volatile("" ::: "memory"); }
            } else { v4u xb[4][2];
#pragma unroll
                for (int m = 0; m < 4; ++m)
#pragma unroll
                    for (int bj = 0; bj < 2; ++bj) xb[m][bj] = *(const GAS v4u*)((const bf16*)xres + off0 + (size_t)(m * 16) * D + bj * 128);
#pragma unroll
                for (int m = 0; m < 4; ++m)
#pragma unroll
                    for (int bj = 0; bj < 2; ++bj) { const pg8::f32x4 a0 = acc[ai][bj][m][0], a1 = acc[ai][bj][m][1]; const v4u x = xb[m][bj];
                        v4u w; w.x = pg8::cvt_pk_bf16(ALPHA * bflo(x.x) + a0[0], ALPHA * bfhi(x.x) + a0[1]); w.y = pg8::cvt_pk_bf16(ALPHA * bflo(x.y) + a0[2], ALPHA * bfhi(x.y) + a0[3]);
                        w.z = pg8::cvt_pk_bf16(ALPHA * bflo(x.z) + a1[0], ALPHA * bfhi(x.z) + a1[1]); w.w = pg8::cvt_pk_bf16(ALPHA * bflo(x.w) + a1[2], ALPHA * bfhi(x.w) + a1[3]);
                        *(GAS v4u*)(O + off0 + (size_t)(m * 16) * D + bj * 128) = w; }
                asm volatile("" ::: "memory"); }
        }
    }
};
struct EpiSwiglu {
    static constexpr bool PERM = true, AFTER_DRAIN = false;
    bf16* H; int ldh; float sc; const float* rs;
    __device__ __forceinline__ void operator()(const pg8::f32x4 (&acc)[2][2][4][2], const pg8::Unit& u, int wr, int wc, int fr, int fq) const {
        { const int ln_ = opq((int)threadIdx.x) & 63; fr = ln_ & 15; fq = ln_ >> 4; }
        float rsv[8];
#pragma unroll
        for (int k = 0; k < 8; ++k) rsv[k] = rs ? rs[u.pm * 256 + (k >> 2) * 128 + wr * 64 + (k & 3) * 16 + fr] : 1.f;
#pragma unroll
        for (int ai = 0; ai < 2; ++ai)
#pragma unroll
            for (int m = 0; m < 4; ++m) { const int row = u.pm * 256 + ai * 128 + wr * 64 + m * 16 + fr;
                const float s1 = sc * rsv[ai * 4 + m];
                const pg8::f32x4 g0 = acc[ai][0][m][0] * s1, g1 = acc[ai][0][m][1] * s1, u0 = acc[ai][1][m][0] * s1, u1 = acc[ai][1][m][1] * s1;
                v4u w; w.x = pg8::cvt_pk_bf16(siluf_(g0[0]) * u0[0], siluf_(g0[1]) * u0[1]); w.y = pg8::cvt_pk_bf16(siluf_(g0[2]) * u0[2], siluf_(g0[3]) * u0[3]);
                w.z = pg8::cvt_pk_bf16(siluf_(g1[0]) * u1[0], siluf_(g1[1]) * u1[1]); w.w = pg8::cvt_pk_bf16(siluf_(g1[2]) * u1[2], siluf_(g1[3]) * u1[3]);
                *(GAS v4u*)(H + (size_t)row * ldh + u.pn * 128 + wc * 32 + 8 * fq) = w; }
    }
};
struct EpiSwiglu8 {
    static constexpr bool PERM = true, AFTER_DRAIN = false;
    unsigned char* H; int ldh; float sc, osc; const float* rs;
    __device__ __forceinline__ void operator()(const pg8::f32x4 (&acc)[2][2][4][2], const pg8::Unit& u, int wr, int wc, int fr, int fq) const {
        { const int ln_ = opq((int)threadIdx.x) & 63; fr = ln_ & 15; fq = ln_ >> 4; }
        float rsv[8];
#pragma unroll
        for (int k = 0; k < 8; ++k) rsv[k] = rs[u.pm * 256 + (k >> 2) * 128 + wr * 64 + (k & 3) * 16 + fr];
#pragma unroll
        for (int ai = 0; ai < 2; ++ai)
#pragma unroll
            for (int m = 0; m < 4; ++m) { const int row = u.pm * 256 + ai * 128 + wr * 64 + m * 16 + fr;
                const float s1 = sc * rsv[ai * 4 + m], s2 = s1 * osc;
                const pg8::f32x4 g0 = acc[ai][0][m][0] * s1, g1 = acc[ai][0][m][1] * s1, u0 = acc[ai][1][m][0] * s2, u1 = acc[ai][1][m][1] * s2;
                float h[8];
#pragma unroll
                for (int i = 0; i < 4; ++i) { h[i] = fminf(fmaxf(siluf_(g0[i]) * u0[i], -448.f), 448.f); h[4 + i] = fminf(fmaxf(siluf_(g1[i]) * u1[i], -448.f), 448.f); }
                v2u w; w.x = pk4_fp8(h[0], h[1], h[2], h[3]); w.y = pk4_fp8(h[4], h[5], h[6], h[7]);
                *(GAS v2u*)(H + (size_t)row * ldh + u.pn * 128 + wc * 32 + 8 * fq) = w; }
    }
};
struct EpiStoreBf {
    static constexpr bool PERM = true, AFTER_DRAIN = false;
    bf16* O; int ldo; float sc;
    __device__ __forceinline__ void operator()(const pg8::f32x4 (&acc)[2][2][4][2], const pg8::Unit& u, int wr, int wc, int fr, int fq) const {
        { const int ln_ = opq((int)threadIdx.x) & 63; fr = ln_ & 15; fq = ln_ >> 4; }
#pragma unroll
        for (int ai = 0; ai < 2; ++ai)
#pragma unroll
            for (int m = 0; m < 4; ++m) { const int row = u.pm * 256 + ai * 128 + wr * 64 + m * 16 + fr;
#pragma unroll
                for (int bj = 0; bj < 2; ++bj) { const pg8::f32x4 v0 = acc[ai][bj][m][0] * sc, v1 = acc[ai][bj][m][1] * sc;
                    v4u w; w.x = pg8::cvt_pk_bf16(v0[0], v0[1]); w.y = pg8::cvt_pk_bf16(v0[2], v0[3]); w.z = pg8::cvt_pk_bf16(v1[0], v1[1]); w.w = pg8::cvt_pk_bf16(v1[2], v1[3]);
                    *(GAS v4u*)(O + (size_t)row * ldo + u.pn * 256 + bj * 128 + wc * 32 + 8 * fq) = w; } }
    }
};
__device__ __forceinline__ void ln_core(f32x4 (&v)[8], const f32x4 (&gg)[8], const f32x4 (&bb)[8]) {
    float s = 0.f;
#pragma unroll
    for (int j = 0; j < 8; ++j) s += (v[j].x + v[j].y) + (v[j].z + v[j].w);
    const float mean = wave_sum(s) * (1.f / D); float s2 = 0.f;
#pragma unroll
    for (int j = 0; j < 8; ++j) { v[j] = v[j] - mean; s2 += (v[j].x * v[j].x + v[j].y * v[j].y) + (v[j].z * v[j].z + v[j].w * v[j].w); }
    const float rstd = rsqrtf(wave_sum(s2) * (1.f / D) + LN_EPS);
#pragma unroll
    for (int j = 0; j < 8; ++j) v[j] = v[j] * rstd * gg[j] + bb[j];
}
template <bool ROUTE> __device__ __forceinline__ void ln_pass(Frame& F, const bf16* __restrict__ PRE, const float* __restrict__ g, const float* __restrict__ b, bf16* __restrict__ Xf, bf16* __restrict__ Xb, unsigned char* __restrict__ X8, float* __restrict__ XS,
                                                              const float* __restrict__ wr, int* __restrict__ tidx, float* __restrict__ tw) {
    const int lane = (opq((int)threadIdx.x) & 63);
    f32x4 gg_[8], bb_[8];
#pragma unroll
    for (int j = 0; j < 8; ++j) { gg_[j] = *(const GAS f32x4*)(g + (j * 64 + lane) * 4); bb_[j] = *(const GAS f32x4*)(b + (j * 64 + lane) * 4); }
    if (ROUTE) {
        LAS f32x4* wl = (LAS f32x4*)F.lds;
        for (int p = opq((int)threadIdx.x); p < 4096; p += 512) { const int ln = p & 63, j = (p >> 6) & 7, hf = (p >> 9) & 1, i = p >> 10;
            const f32x4 w = *(const GAS f32x4*)(wr + (size_t)((j * 64 + ln) * 4 + i) * 8 + hf * 4); wl[p] = w; }
        __syncthreads(); }
    v2u nv[8];
    { const int t0_ = opq_s(F.gw);
#pragma unroll
      for (int j = 0; j < 8; ++j) nv[j] = *(const GAS v2u*)(PRE + (size_t)t0_ * D + (j * 64 + lane) * 4); }
    for (int t = opq_s(F.gw); t < M; t += F.NGW) {
        f32x4 v[8];
#pragma unroll
        for (int j = 0; j < 8; ++j) v[j] = (f32x4){bflo(nv[j].x), bfhi(nv[j].x), bflo(nv[j].y), bfhi(nv[j].y)};
        { const int tn = (t + F.NGW < M) ? t + F.NGW : t;
#pragma unroll
          for (int j = 0; j < 8; ++j) nv[j] = *(const GAS v2u*)(PRE + (size_t)tn * D + (j * 64 + lane) * 4); }
        ln_core(v, gg_, bb_);
#pragma unroll
        for (int j = 0; j < 8; ++j) { { v2u w; w.x = pk2(v[j].x, v[j].y); w.y = pk2(v[j].z, v[j].w); *(GAS v2u*)(Xf + (size_t)t * D + (j * 64 + lane) * 4) = w; }
            if (Xb) { v2u w; w.x = pk2(v[j].x, v[j].y); w.y = pk2(v[j].z, v[j].w); *(GAS v2u*)(Xb + (size_t)t * D + (j * 64 + lane) * 4) = w; }
            }
        if (X8) {
            float am = 0.f;
#pragma unroll
            for (int j = 0; j < 8; ++j) am = fmaxf(am, fmaxf(fmaxf(fabsf(v[j].x), fabsf(v[j].y)), fmaxf(fabsf(v[j].z), fabsf(v[j].w))));
            am = fmaxf(wave_max(am), 1e-20f); const float q = 127.f / am; if (lane == 0) XS[t] = am * (1.f / 127.f);
#pragma unroll
            for (int j = 0; j < 8; ++j) *(GAS unsigned*)(X8 + (size_t)t * D + (j * 64 + lane) * 4) = pk4_i8(v[j].x * q, v[j].y * q, v[j].z * q, v[j].w * q); }
        if (ROUTE) {
            float lg[8];
#pragma unroll
            for (int e = 0; e < 8; ++e) lg[e] = 0.f;
#pragma unroll
            for (int j = 0; j < 8; ++j) { const float xv[4] = {v[j].x, v[j].y, v[j].z, v[j].w};
#pragma unroll
                for (int i = 0; i < 4; ++i) { const LAS f32x4* wl = (const LAS f32x4*)F.lds; const f32x4 w0 = wl[((i * 2 + 0) * 8 + j) * 64 + lane], w1 = wl[((i * 2 + 1) * 8 + j) * 64 + lane];
                    lg[0] = fmaf(xv[i], w0.x, lg[0]); lg[1] = fmaf(xv[i], w0.y, lg[1]); lg[2] = fmaf(xv[i], w0.z, lg[2]); lg[3] = fmaf(xv[i], w0.w, lg[3]);
                    lg[4] = fmaf(xv[i], w1.x, lg[4]); lg[5] = fmaf(xv[i], w1.y, lg[5]); lg[6] = fmaf(xv[i], w1.z, lg[6]); lg[7] = fmaf(xv[i], w1.w, lg[7]); }
                asm volatile("" ::: "memory"); }
#pragma unroll
            for (int e = 0; e < 8; ++e) lg[e] = wave_sum(lg[e]);
            if (lane == 0) {
                int i0 = 0; float v0 = lg[0];
#pragma unroll
                for (int e = 1; e < 8; ++e) if (lg[e] > v0) { v0 = lg[e]; i0 = e; }
                int i1 = -1; float v1 = -__builtin_inff();
#pragma unroll
                for (int e = 0; e < 8; ++e) if (e != i0 && lg[e] > v1) { v1 = lg[e]; i1 = e; }
                const float e1 = __expf(v1 - v0);
                tidx[t * 2] = i0; tidx[t * 2 + 1] = i1; tw[t * 2] = 1.f / (1.f + e1); tw[t * 2 + 1] = e1 / (1.f + e1);
            }
        }
    }
}
__device__ __forceinline__ void ln_moe_pass(Frame& F, const bf16* __restrict__ X1, const bf16* __restrict__ OS, const int* __restrict__ pos, const float* __restrict__ tw,
                                            const float* __restrict__ g, const float* __restrict__ b, float* __restrict__ out, const float* __restrict__ PT, float ptsc) {
    const int lane = (opq((int)threadIdx.x) & 63);
    f32x4 gg_[8], bb_[8];
#pragma unroll
    for (int jj = 0; jj < 8; ++jj) { gg_[jj] = *(const GAS f32x4*)(g + (jj * 64 + lane) * 4); bb_[jj] = *(const GAS f32x4*)(b + (jj * 64 + lane) * 4); }
    for (int t = opq_s(F.gw); t < M; t += F.NGW) {
        const int p0 = pos[t * 2], p1 = pos[t * 2 + 1]; const float w0 = tw[t * 2], w1 = tw[t * 2 + 1];
        f32x4 v[8];
#pragma unroll
        for (int j = 0; j < 8; ++j) { const v2u xb = *(const GAS v2u*)(X1 + (size_t)t * D + (j * 64 + lane) * 4); const f32x4 x = (f32x4){bflo(xb.x), bfhi(xb.x), bflo(xb.y), bfhi(xb.y)};
            f32x4 ea, ec;
            if (PT && p0 >= TAIL_RT0 * 256) { const float* q_ = PT + (size_t)(p0 - TAIL_RT0 * 256) * D + (j * 64 + lane) * 4;
                ea = (*(const GAS f32x4*)q_ + *(const GAS f32x4*)(q_ + (size_t)TAIL_ROWS * D) + *(const GAS f32x4*)(q_ + (size_t)2 * TAIL_ROWS * D) + *(const GAS f32x4*)(q_ + (size_t)3 * TAIL_ROWS * D)) * ptsc; }
            else { const v2u a = *(const GAS v2u*)(OS + (size_t)p0 * D + (j * 64 + lane) * 4); ea = (f32x4){bflo(a.x), bfhi(a.x), bflo(a.y), bfhi(a.y)}; }
            if (PT && p1 >= TAIL_RT0 * 256) { const float* q_ = PT + (size_t)(p1 - TAIL_RT0 * 256) * D + (j * 64 + lane) * 4;
                ec = (*(const GAS f32x4*)q_ + *(const GAS f32x4*)(q_ + (size_t)TAIL_ROWS * D) + *(const GAS f32x4*)(q_ + (size_t)2 * TAIL_ROWS * D) + *(const GAS f32x4*)(q_ + (size_t)3 * TAIL_ROWS * D)) * ptsc; }
            else { const v2u c = *(const GAS v2u*)(OS + (size_t)p1 * D + (j * 64 + lane) * 4); ec = (f32x4){bflo(c.x), bfhi(c.x), bflo(c.y), bfhi(c.y)}; }
            v[j] = ALPHA * x + w0 * ea + w1 * ec; }
        ln_core(v, gg_, bb_);
#pragma unroll
        for (int j = 0; j < 8; ++j) *(GAS f32x4*)(out + (size_t)t * D + (j * 64 + lane) * 4) = v[j];
    }
}
__device__ __forceinline__ void moe_dispatch(Frame& F, const int* __restrict__ tidx, const unsigned char* __restrict__ X8, const float* __restrict__ XS, unsigned char* __restrict__ XG, float* __restrict__ XGS, int* __restrict__ pos, int* __restrict__ cntg, LAS unsigned char* lds) {
    const int tid = opq((int)threadIdx.x), lane = tid & 63, wv = __builtin_amdgcn_readfirstlane(tid >> 6);
    LAS int* sc = (LAS int*)lds;
    for (int blk = blockIdx.x; blk < 256; blk += F.G) {
        const int s_lo = blk * 128;
        int ct[8], cp[8];
#pragma unroll
        for (int e = 0; e < 8; ++e) { ct[e] = 0; cp[e] = 0; }
        for (int ib = 0; ib < 16; ib += 8) { v4u ev[8];
#pragma unroll
          for (int it = 0; it < 8; ++it) ev[it] = *(const GAS v4u*)(tidx + ((ib + it) * 512 + tid) * 4);
#pragma unroll
          for (int it = 0; it < 8; ++it) { const int s0 = ((ib + it) * 512 + tid) * 4; const int ee[4] = {(int)ev[it].x, (int)ev[it].y, (int)ev[it].z, (int)ev[it].w};
#pragma unroll
              for (int j = 0; j < 4; ++j)
#pragma unroll
                  for (int k = 0; k < 8; ++k) { const int hit = (ee[j] == k); ct[k] += hit; cp[k] += (hit && s0 + j < s_lo); } } }
#pragma unroll
        for (int e = 0; e < 8; ++e) { for (int o = 32; o >= 1; o >>= 1) { ct[e] += __shfl_xor(ct[e], o); cp[e] += __shfl_xor(cp[e], o); } }
        if (lane == 0) {
#pragma unroll
            for (int e = 0; e < 8; ++e) { sc[wv * 16 + e] = ct[e]; sc[wv * 16 + 8 + e] = cp[e]; } }
        __syncthreads();
        if (tid < 16) { int a = 0; for (int w = 0; w < 8; ++w) a += sc[w * 16 + tid]; sc[128 + tid] = a; }
        __syncthreads();
        if (tid == 0) { int o = 0; for (int e = 0; e < 8; ++e) { sc[160 + e] = o; o += (sc[128 + e] + 255) & ~255; if (blk == 0) cntg[e] = sc[128 + e]; } }
        __syncthreads();
        if (wv < 2) { const int s = s_lo + tid; const int e = tidx[s]; int rank = 0, mycnt = 0;
#pragma unroll
            for (int k = 0; k < 8; ++k) { const unsigned long long m = __ballot(e == k); if (e == k) rank = __popcll(m & ((1ull << lane) - 1ull)); if (wv == 0 && lane == k) mycnt = __popcll(m); }
            if (wv == 0 && lane < 8) sc[320 + lane] = mycnt; }
        __syncthreads();
        if (wv < 2) { const int s = s_lo + tid; const int e = tidx[s]; int rank = 0;
#pragma unroll
            for (int k = 0; k < 8; ++k) { const unsigned long long m = __ballot(e == k); if (e == k) rank = __popcll(m & ((1ull << lane) - 1ull)); }
            const int p = sc[160 + e] + sc[128 + 8 + e] + (wv == 1 ? sc[320 + e] : 0) + rank;
            pos[s] = p; sc[192 + tid] = p; }
        __syncthreads();
        for (int i0 = wv; i0 < 128; i0 += 32) {
            v4u r0[4], r1[4]; float xs[4];
#pragma unroll
            for (int k = 0; k < 4; ++k) { const int s = s_lo + i0 + 8 * k; const v4u* src = (const v4u*)(X8 + (size_t)(s >> 1) * D) + lane * 2; r0[k] = src[0]; r1[k] = src[1]; xs[k] = XS[s >> 1]; }
#pragma unroll
            for (int k = 0; k < 4; ++k) { const int p = sc[192 + i0 + 8 * k]; v4u* dst = (v4u*)(XG + (size_t)p * D) + lane * 2; dst[0] = r0[k]; dst[1] = r1[k]; if (lane == 0) XGS[p] = xs[k]; } }
        if (blk < 8) { const int c = sc[128 + blk], r0 = sc[160 + blk] + c, r1 = sc[160 + blk] + ((c + 255) & ~255); const unsigned zz = (unsigned)opq(0); const v4u z = {zz, zz, zz, zz};
            for (int i = r0 * 128 + tid; i < r1 * 128; i += 512) ((GAS v4u*)XG)[i] = z;
            for (int i = r0 + tid; i < r1; i += 512) XGS[i] = 0.f; }
        __syncthreads();
    }
}
struct OrderMoE {
    int G_, c, nN, ntile; int tl[8];
    __device__ __forceinline__ void init(const int* cnt, int nN_, int G__, int c_) { G_ = G__; c = c_; nN = nN_; ntile = 0;
#pragma unroll
        for (int e = 0; e < 8; ++e) { tl[e] = __builtin_amdgcn_readfirstlane((cnt[e] + 255) >> 8); ntile += tl[e]; } }
    __device__ bool next(int i, pg8::Unit& u) const {
        const int nwg = ntile * nN; const long L_ = (long)i * G_ + c; if (L_ >= nwg) return false;
        int wgid = (int)L_; { const int q = nwg / 8, r = nwg % 8, xcd = wgid % 8, off = wgid / 8; wgid = (xcd < r ? xcd * (q + 1) : r * (q + 1) + (xcd - r) * q) + off; }
        const int nig = 8 * nN, gid = wgid / nig, fm = gid * 8, gsz = (ntile - fm) < 8 ? (ntile - fm) : 8;
        const int rt = fm + ((wgid % nig) % gsz), pn = (wgid % nig) / gsz;
        int e = 0, cum = 0;
#pragma unroll
        for (int k = 0; k < 8; ++k) { cum += tl[k]; e += (rt >= cum) ? 1 : 0; }
        if (e > 7) e = 7;
        u.pm = rt; u.pn = pn; u.pa = rt; u.pb = e * nN + pn; return true;
    }
    __device__ __forceinline__ void a_ready(const pg8::Unit&) const {} __device__ __forceinline__ void done(const pg8::Unit&) const {}
};
struct OrderTail {
    int c, ntile; int tl[8];
    __device__ __forceinline__ void init(const int* cnt, int c_) { c = c_; ntile = 0;
#pragma unroll
        for (int e = 0; e < 8; ++e) { tl[e] = __builtin_amdgcn_readfirstlane((cnt[e] + 255) >> 8); ntile += tl[e]; } }
    __device__ bool next(int i, pg8::Unit& u) const {
        if (i > 0) return false;
        const int tu = c >> 2, rt = TAIL_RT0 + (tu >> 3), pn = tu & 7; if (rt >= ntile) return false;
        int e = 0, cum = 0;
#pragma unroll
        for (int k = 0; k < 8; ++k) { cum += tl[k]; e += (rt >= cum) ? 1 : 0; }
        if (e > 7) e = 7;
        u.pm = tu >> 3; u.pn = pn; u.pa = rt; u.pb = e * 8 + pn; return true;
    }
    __device__ __forceinline__ void a_ready(const pg8::Unit&) const {} __device__ __forceinline__ void done(const pg8::Unit&) const {}
};
struct EpiTail {
    static constexpr bool PERM = true, AFTER_DRAIN = false;
    float* P;
    __device__ __forceinline__ void operator()(const pg8::f32x4 (&acc)[2][2][4][2], const pg8::Unit& u, int wr, int wc, int fr, int fq) const {
        { const int ln_ = opq((int)threadIdx.x) & 63; fr = ln_ & 15; fq = ln_ >> 4; }
#pragma unroll
        for (int ai = 0; ai < 2; ++ai)
#pragma unroll
            for (int m = 0; m < 4; ++m) { const int row = u.pm * 256 + ai * 128 + wr * 64 + m * 16 + fr;
#pragma unroll
                for (int bj = 0; bj < 2; ++bj) { float* o = P + (size_t)row * D + u.pn * 256 + bj * 128 + wc * 32 + 8 * fq;
                    *(GAS f32x4*)o = (f32x4){acc[ai][bj][m][0][0], acc[ai][bj][m][0][1], acc[ai][bj][m][0][2], acc[ai][bj][m][0][3]};
                    *(GAS f32x4*)(o + 4) = (f32x4){acc[ai][bj][m][1][0], acc[ai][bj][m][1][1], acc[ai][bj][m][1][2], acc[ai][bj][m][1][3]}; }
                asm volatile("" ::: "memory"); }
    }
};
#ifndef REP_PHASE
#define REP_PHASE -1
#endif
#define REPB(k) for (int rep_ = 0, nrep_ = ((REP_PHASE == (k)) ? opq_s(2) : 1); rep_ < nrep_; ++rep_)
struct Args { const float* in[30]; float* out; unsigned char* ws; int ph_lo, ph_hi, li, prep_mask; };
constexpr int NPH_L = 11;
__device__ __forceinline__ unsigned char* wsl(unsigned char* p) { asm volatile("" : "+s"(p)); return p; }
__device__ __forceinline__ const float* ain(const Args& a, int i) { return a.in[opq_s(i)]; }

#ifndef MOE_Q0
#define MOE_Q0 12
#endif
#ifndef MOE_Q1
#define MOE_Q1 8
#endif
#ifndef MOE_Q2
#define MOE_Q2 12
#endif
constexpr int MOE_IT_M = (D / 64) * (DFE / 32);
constexpr int MOE_NITEMS = NE * 3 * MOE_IT_M;
constexpr int MOE_QL = MOE_Q0 + MOE_Q1 + MOE_Q2;
constexpr int MOE_DEFER = 2 * MOE_QL * 128 * NWAVES;
static_assert(MOE_DEFER <= MOE_NITEMS, "deferred quota exceeds the item count");
__device__ __forceinline__ void moe_item_load(f32x4 (&ld)[8], const Args& a, int id, int lane) {
    const int e = id / (3 * MOE_IT_M), r = id % (3 * MOE_IT_M), mtx = r / MOE_IT_M, it = r % MOE_IT_M;
    if (mtx == 2) tr_load(ld, ain(a, 29) + (size_t)e * DFE * D, D, D, it, lane);
    else tr_load(ld, ain(a, 27 + mtx) + (size_t)e * D * DFE, DFE, DFE, it, lane);
}
__device__ __forceinline__ void moe_item_store(const f32x4 (&ld)[8], Frame& F, int id, int lane) {
    unsigned char* ws = F.ws; LAS float* scr = (LAS float*)(F.lds + F.wave * 16384);
    const int e = id / (3 * MOE_IT_M), r = id % (3 * MOE_IT_M), mtx = r / MOE_IT_M, it = r % MOE_IT_M;
    if (mtx == 0) tr_store8<2, true>(ld, D, DFE, wsl(ws) + WS_MOEGU + e * (MOEGU_E / 2), WI8_Q, scr, it, lane);
    else if (mtx == 1) tr_store8<3, true>(ld, D, DFE, wsl(ws) + WS_MOEGU + e * (MOEGU_E / 2), WI8_Q, scr, it, lane);
    else tr_store8<0, false>(ld, DFE, D, wsl(ws) + WS_MOED + e * (MOED_E / 2), WD8_SCALE, scr, it, lane);
}
__device__ __forceinline__ void moe_cvt_range(Frame& F, const Args& a, int first, int last, int step, int lane) {
    if (first >= last) return;
    f32x4 ld[8], nx[8]; moe_item_load(ld, a, first, lane);
    for (int id = first; id < last; id += step) {
        const int idn = (id + step < last) ? id + step : id; moe_item_load(nx, a, idn, lane);
        moe_item_store(ld, F, id, lane);
#pragma unroll
        for (int i = 0; i < 8; ++i) ld[i] = nx[i]; }
}
__device__ __forceinline__ void moe_cvt_window(Frame& F, const Args& a, int l, int w) {
    if (F.G != 256 || (int)blockIdx.x < 128) return;
    const int q = (w == 0) ? MOE_Q0 : (w == 1) ? MOE_Q1 : MOE_Q2, woff = (w == 0) ? 0 : (w == 1) ? MOE_Q0 : MOE_Q0 + MOE_Q1;
    const int sw = ((int)blockIdx.x - 128) * NWAVES + F.wave, lane = opq((int)threadIdx.x) & 63;
    const int base = (l * MOE_QL + woff) * 1024 + sw * q;
    moe_cvt_range(F, a, base, base + q, 1, lane);
    __syncthreads();
}
__device__ __forceinline__ s5::Par s5par(const Args& a, int l) {
    return s5::Par{ain(a, 3) + l * 2048, ain(a, 4) + l * 2048, ain(a, 5) + (size_t)l * 32768, ain(a, 6) + (size_t)l * 32768, ain(a, 7) + (size_t)l * 32768, ain(a, 8) + (size_t)l * 32768, ain(a, 9) + l * 512, ain(a, 10) + l * 32};
}
__device__ __forceinline__ void prologue2(Frame& F, const Args& a) {
    if (a.prep_mask & 8) for (int l = 0; l < 2; ++l) { const s5::Par q = s5par(a, l);
        s5::gen_mats(F, q, (const float*)(wsl(F.ws) + WS_SMALL + SM_S5KC) + (size_t)l * 32 * 64 * 256, (const float2*)(wsl(F.ws) + WS_S5PW) + (size_t)l * 32 * 64 * 66, (bf16*)(wsl(F.ws) + WS_S5K + l * S5K_L), (bf16*)(wsl(F.ws) + WS_S5H + l * S5H_L)); }
}
__device__ __forceinline__ void prologue(Frame& F, const Args& a) {
    const int pm = a.prep_mask;
    unsigned char* ws = F.ws;
    if (pm & 1) {
        float2* rope = (float2*)(wsl(ws) + WS_ROPE);
        for (int i = F.gw * 64 + (opq((int)threadIdx.x) & 63); i < M * 32; i += F.NGW * 64) { const int t = i >> 5, j = i & 31; const float inv = powf(10000.f, -(float)(2 * j) / 64.f); const float ang = (float)t * inv; rope[i] = make_float2(cosf(ang), sinf(ang)); }
        quant_rows_job(F, ain(a, 0), wsl(ws) + WS_X8, (float*)(wsl(ws) + WS_SMALL + SM_XS), M);
    }
    if (pm & 16) {
        float* lbv = (float*)(wsl(ws) + WS_SMALL + SM_LB);
        for (int i = F.gw * 64 + (opq((int)threadIdx.x) & 63); i < 512; i += F.NGW * 64) { const float l0 = ain(a, 17)[i], l1 = ain(a, 17)[512 + i]; const float m = fmaxf(l0, l1), e0 = expf(l0 - m), e1 = expf(l1 - m);
            const float p0 = e0 / (e0 + e1), p1 = e1 / (e0 + e1); lbv[i] = 0.f; lbv[512 + i] = (p0 + p1) - p0; }
    }
    if (pm & 64) {
        transpose_job8<2, true>(F, ain(a, 23), D, DFF, DFF, wsl(ws) + WS_FFNGU, WI8_Q);
        transpose_job8<3, true>(F, ain(a, 24), D, DFF, DFF, wsl(ws) + WS_FFNGU, WI8_Q);
        transpose_job<0>(F, ain(a, 25), DFF, D, D, (bf16*)(wsl(ws) + WS_FFND), 0, nullptr, 1.f);
    }
    if (pm & 128) { const int lane = opq((int)threadIdx.x) & 63; const int first = (F.G == 256) ? MOE_DEFER : 0;
        moe_cvt_range(F, a, first + opq_s(F.gw), MOE_NITEMS, F.NGW, lane); }
    for (int l = 0; l < 2; ++l) {
        if (pm & 2) {
            transpose_job8<0, true>(F, ain(a, 1) + (size_t)l * D * INC, D, INC, INC, wsl(ws) + WS_WIN + l * WIN_L, WI8_Q);
            zero_job(F, wsl(ws) + WS_WIN + l * WIN_L + (size_t)INC * D, (size_t)(NPROJ - INC) * D);
        }
        if (pm & 4) {
            transpose_job<0>(F, ain(a, 14) + (size_t)l * QR * QLD, QR, QLD, QLD, (bf16*)(wsl(ws) + WS_WUQ + l * WUQ_L), 0, ain(a, 13) + l * QR, QSCALE);
            transpose_job<0>(F, ain(a, 16) + (size_t)l * KVR * 2048, KVR, 2048, 2048, (bf16*)(wsl(ws) + WS_WUKV + l * WUKV_L), 0, ain(a, 15) + l * KVR, 1.f);
        }
        if (pm & 32) transpose_job<0>(F, ain(a, 2) + (size_t)l * D * D, D, D, D, (bf16*)(wsl(ws) + WS_WOUT + l * WOUT_L), 0, nullptr, 1.f);
        if (pm & 8) {
            const s5::Par q = s5par(a, l);
            s5::gen_kc(F, q, (float*)(wsl(ws) + WS_SMALL + SM_S5KC) + (size_t)l * 32 * 64 * 256);
            s5::gen_pw(F, q, (float2*)(wsl(ws) + WS_S5PW) + (size_t)l * 32 * 64 * 66);
            transpose_job<0>(F, ain(a, 11) + (size_t)l * 512 * 512, 512, 512, 512, (bf16*)(wsl(ws) + WS_WGLU + l * WGLU_L), 0, nullptr, 1.f);
        }
    }
}

#define XB ((bf16*)(wsl(ws) + WS_XB))
#define PROJ ((bf16*)(wsl(ws) + WS_PROJ))
#define U2 ((bf16*)(wsl(ws) + WS_U2))
#define Qb ((bf16*)(wsl(ws) + WS_Q))
#define Kb ((unsigned char*)(wsl(ws) + WS_K))
#define Vb ((unsigned char*)(wsl(ws) + WS_V))
#define YCAT ((bf16*)(wsl(ws) + WS_YCAT))
#define YG ((bf16*)(wsl(ws) + WS_YG))
#define Ebuf ((float*)(wsl(ws) + WS_E))
#define HGU ((float*)(wsl(ws) + WS_HGU))
#define HGS ((bf16*)(wsl(ws) + WS_HGS))
#define HGG ((float*)(wsl(ws) + WS_HGG))
#define lbl ((const float*)(wsl(ws) + WS_SMALL + SM_LB) + l * 512)
#define rstdq ((float*)(wsl(ws) + WS_SMALL + SM_RSTDQ))
#define rstdkv ((float*)(wsl(ws) + WS_SMALL + SM_RSTDKV))
#define rope ((const float2*)(wsl(ws) + WS_ROPE))
#define PRE ((bf16*)(wsl(ws) + WS_PRE))
#define R0 ((bf16*)(wsl(ws) + WS_R0))
#define R1 ((bf16*)(wsl(ws) + WS_R1))
#define TIDX ((int*)(wsl(ws) + WS_SMALL + SM_TIDX))
#define TW ((float*)(wsl(ws) + WS_SMALL + SM_TW))
#define POS ((int*)(wsl(ws) + WS_SMALL + SM_POS))
#define CNT ((int*)(wsl(ws) + WS_SMALL + SM_CNT))
__global__ void __launch_bounds__(NWAVES * 64, 2) mk_fwd(Args args) {
    extern __shared__ __attribute__((aligned(16))) unsigned char lds[];
    Frame F;
    F.lds = (LAS unsigned char*)lds;
    F.MISC = (volatile LAS unsigned*)(F.lds + MISC_OFF);
    F.wave = __builtin_amdgcn_readfirstlane((int)threadIdx.x >> 6);
    F.G = gridDim.x; F.gw = blockIdx.x * NWAVES + F.wave; F.NGW = F.G * NWAVES;
    F.ws = args.ws; F.ctl = (gu32*)(args.ws + WS_CTL);
    unsigned char* ws = args.ws;
    for (int u = threadIdx.x; u < (LDS_BYTES - LDSCTL_OFF) / 4; u += NWAVES * 64) ((LAS unsigned*)(F.lds + LDSCTL_OFF))[u] = 0u;
    __syncthreads();
    XcdBarrier bar = xcd_barrier_post((unsigned*)(F.ctl + CW_BAR) + args.li * XCD_BAR_WORDS, F.MISC + 8);
    const int lo = args.ph_lo, hi = args.ph_hi;
#define IN(k) (lo <= (k) && (k) < hi)
#define SEAM(k) do { if (IN(k) && IN((k) + 1)) xcd_barrier(bar); } while (0)
    if (IN(0)) { REPB(100) prologue(F, args); } SEAM(0);
    if (IN(1)) { REPB(101) prologue2(F, args); } SEAM(1);
    for (int l = 0; l < 2; ++l) {
        const int pb = 2 + l * NPH_L;


        if (IN(pb + 0)) REPB(0) {
#ifndef NO_G0
            pg8::Gemm g{(const bf16*)(wsl(ws) + WS_X8), (const bf16*)(wsl(ws) + WS_WIN + l * WIN_L), M, NPROJ, D / 2, D / 2}; pg8::StaticOrder S; S.init(M, NPROJ, F.G, (int)blockIdx.x);
            EpiProj E{PROJ, U2, WI8_S, (const float*)(wsl(ws) + WS_SMALL + SM_XS)};
            pg8::gemm_phase_i8<EpiProj, pg8::StaticOrder, true, true>(F.lds, g, S, E);
#endif
            moe_cvt_window(F, args, l, 0);
        }
        SEAM(pb + 0);
        if (IN(pb + 1)) REPB(1) { thin_mla(F, PROJ, rstdq, rstdkv, Kb, rope);
#ifndef NO_S5
            { pg8::Gemm g{U2, (const bf16*)(wsl(ws) + WS_S5H + l * S5H_L), 32 * 256, 256, 1024, 1152}; s5::OrderE S{F.G, (int)blockIdx.x}; s5::EpiE E{Ebuf};
              pg8::gemm_phase<s5::EpiE, s5::OrderE, true, true>(F.lds, g, S, E); }
#endif
#ifndef NO_HG
            if (F.G == 256) { if ((int)blockIdx.x >= 32) for (int u = (int)blockIdx.x - 32; u < 1024; u += 224) hg::unit_a(u, PROJ, lbl, HGU, HGG, F.lds); }
            else for (int u = blockIdx.x; u < 1024; u += F.G) hg::unit_a(u, PROJ, lbl, HGU, HGG, F.lds);
#endif
        }
        SEAM(pb + 1);
        if (IN(pb + 2)) REPB(2) {
#ifndef NO_S5
            s5::carry(F, (F.G >= 256 ? 192 : 0) * NWAVES, s5par(args, l), Ebuf, U2);
#endif
#ifndef NO_HG
            hg::scan_b(F, (F.G >= 256 ? 128 : 0) * NWAVES, HGU, HGG, HGS);
#endif
#ifndef NO_G2
            { pg8::Gemm g{PROJ + P_CQ, (const bf16*)(wsl(ws) + WS_WUQ + l * WUQ_L), M, QLD, QR, NPROJ}; pg8::StaticOrder S; S.init(M, QLD, F.G, (int)blockIdx.x);
              EpiRS<false> E{Qb, nullptr, nullptr, rstdq};
              pg8::gemm_phase<EpiRS<false>, pg8::StaticOrder, true, true>(F.lds, g, S, E); }
            { pg8::Gemm g{PROJ + P_CKV, (const bf16*)(wsl(ws) + WS_WUKV + l * WUKV_L), M, 2048, KVR, NPROJ}; pg8::StaticOrder S; S.init(M, 2048, F.G, (int)blockIdx.x);
              EpiRS<true> E{nullptr, Kb, Vb, rstdkv};
              pg8::gemm_phase<EpiRS<true>, pg8::StaticOrder, true, true>(F.lds, g, S, E); }
#endif
        }
        SEAM(pb + 2);
        if (IN(pb + 3)) REPB(3) {
#ifndef NO_S5
            REPB(33) { pg8::Gemm g{U2, (const bf16*)(wsl(ws) + WS_S5K + l * S5K_L), 32 * 256, 1024, 1152, 1152}; s5::OrderY S{F.G, (int)blockIdx.x}; s5::EpiY E{YG};
              pg8::gemm_phase<s5::EpiY, s5::OrderY, true, true>(F.lds, g, S, E); }
#endif
            moe_cvt_window(F, args, l, 1);
#ifndef NO_HG
            REPB(30) for (int u = blockIdx.x; u < 1024; u += F.G) hg::unit_c(u, PROJ, lbl, HGS, ain(args, 18) + l * 128, YCAT, F.lds);
#endif
#ifndef NO_ATTN
            for (int u2 = blockIdx.x * 2, nu2_ = (REP_PHASE == 32) ? opq_s(1024) : 512; u2 < nu2_; u2 += F.G * 2) for (int s = 0; s < 2; ++s) { const int u = (u2 >> 1) & 255, h = u & 7, pi = u >> 3;
#if REP_PHASE == 32
                if (u2 < 512) at8::attn_unit<PVAR>(h, s ? pi : 63 - pi, Qb, Kb, Vb, rope, YCAT, D, 512, (LAS char*)F.lds); else
#endif
                at8::attn_unit<0>(h, s ? pi : 63 - pi, Qb, Kb, Vb, rope, YCAT, D, 512, (LAS char*)F.lds); }
#endif
        }
        SEAM(pb + 3);
        if (IN(pb + 4)) REPB(4) {
#ifndef NO_S5
            pg8::Gemm g{YG, (const bf16*)(wsl(ws) + WS_WGLU + l * WGLU_L), M, 512, 512, 512}; pg8::StaticOrder S; S.init(M, 512, F.G, (int)blockIdx.x); s5::EpiGlu E{YG, ain(args, 12) + l * 512, YCAT};
            pg8::gemm_phase<s5::EpiGlu, pg8::StaticOrder, true, true>(F.lds, g, S, E);
#endif
            moe_cvt_window(F, args, l, 2);
        }
        SEAM(pb + 4);


        if (IN(pb + 5)) REPB(5) {
#ifndef NO_P5
            pg8::Gemm g{YCAT, (const bf16*)(wsl(ws) + WS_WOUT + l * WOUT_L), M, D, D, D}; pg8::StaticOrder S; S.init(M, D, F.G, (int)blockIdx.x); EpiRes E{l == 0 ? (const void*)ain(args, 0) : (const void*)R1, PRE, l == 0};
            pg8::gemm_phase<EpiRes, pg8::StaticOrder, true, true>(F.lds, g, S, E);
#endif
        }
        SEAM(pb + 5);
        if (IN(pb + 6)) REPB(6) {
#ifndef NO_P6
            if (l == 0) ln_pass<false>(F, PRE, ain(args, 19), ain(args, 20), R0, nullptr, wsl(ws) + WS_X8, (float*)(wsl(ws) + WS_SMALL + SM_XS), nullptr, nullptr, nullptr);
            else ln_pass<true>(F, PRE, ain(args, 19) + D, ain(args, 20) + D, R0, nullptr, wsl(ws) + WS_X8, (float*)(wsl(ws) + WS_SMALL + SM_XS), ain(args, 26), TIDX, TW);
#endif
        }
        SEAM(pb + 6);
        if (IN(pb + 7)) REPB(7) {
#ifndef NO_P7
            if (l == 0) { pg8::Gemm g{(const bf16*)(wsl(ws) + WS_X8), (const bf16*)(wsl(ws) + WS_FFNGU), M, 2 * DFF, D / 2, D / 2}; pg8::StaticOrder S; S.init(M, 2 * DFF, F.G, (int)blockIdx.x);
                EpiSwiglu E{(bf16*)(wsl(ws) + WS_H), DFF, WI8_S, (const float*)(wsl(ws) + WS_SMALL + SM_XS)};
                pg8::gemm_phase_i8<EpiSwiglu, pg8::StaticOrder, true, true>(F.lds, g, S, E); }
            else moe_dispatch(F, TIDX, wsl(ws) + WS_X8, (const float*)(wsl(ws) + WS_SMALL + SM_XS), wsl(ws) + WS_XG8, (float*)(wsl(ws) + WS_SMALL + SM_XGS), POS, CNT, F.lds);
#endif
        }
        SEAM(pb + 7);
        if (IN(pb + 8)) REPB(8) {
#ifndef NO_P8
            if (l == 0) { pg8::Gemm g{(const bf16*)(wsl(ws) + WS_H), (const bf16*)(wsl(ws) + WS_FFND), M, D, DFF, DFF}; pg8::StaticOrder S; S.init(M, D, F.G, (int)blockIdx.x); EpiRes E{R0, PRE, 0};
                pg8::gemm_phase<EpiRes, pg8::StaticOrder, true, true>(F.lds, g, S, E); }
            else { pg8::Gemm g{(const bf16*)(wsl(ws) + WS_XG8), (const bf16*)(wsl(ws) + WS_MOEGU), 34816, 2 * DFE, D / 2, D / 2}; OrderMoE S; S.init(CNT, 56, F.G, (int)blockIdx.x);
                EpiSwiglu8 E{wsl(ws) + WS_HM, DFE, WI8_S, H8_SCALE, (const float*)(wsl(ws) + WS_SMALL + SM_XGS)};
                pg8::gemm_phase_i8<EpiSwiglu8, OrderMoE, true, true>(F.lds, g, S, E); }
#endif
        }
        SEAM(pb + 8);
        if (IN(pb + 9)) REPB(9) {
#ifndef NO_P9
            if (l == 0) ln_pass<false>(F, PRE, ain(args, 21), ain(args, 22), R1, nullptr, wsl(ws) + WS_X8, (float*)(wsl(ws) + WS_SMALL + SM_XS), nullptr, nullptr, nullptr);
            else { pg8::Gemm g{(const bf16*)(wsl(ws) + WS_HM), (const bf16*)(wsl(ws) + WS_MOED), 34816, D, DFE / 2, DFE / 2}; OrderMoE S; S.init(CNT, 8, F.G, (int)blockIdx.x);
                if (F.G == 256 && S.ntile > TAIL_RT0) S.ntile = TAIL_RT0;
                EpiStoreBf E{(bf16*)(wsl(ws) + WS_OS), D, 1.f / (H8_SCALE * WD8_SCALE)};
                pg8::gemm_phase8<EpiStoreBf, OrderMoE, true, true>(F.lds, g, S, E);
                if (F.G == 256) { const int ks = (int)blockIdx.x & 3; OrderTail T; T.init(CNT, (int)blockIdx.x);
                    pg8::Gemm g2{(const bf16*)(wsl(ws) + WS_HM) + ks * (DFE / 8), (const bf16*)(wsl(ws) + WS_MOED) + ks * (DFE / 8), 34816, D, DFE / 8, DFE / 2, DFE / 2};
                    EpiTail E2{(float*)(wsl(ws) + WS_H) + (size_t)ks * TAIL_ROWS * D};
                    pg8::gemm_phase8<EpiTail, OrderTail, true, true>(F.lds, g2, T, E2); } }
#endif
        }
        SEAM(pb + 9);
        if (IN(pb + 10)) REPB(10) {
#ifndef NO_P10
            if (l == 1) ln_moe_pass(F, R0, (const bf16*)(wsl(ws) + WS_OS), POS, TW, ain(args, 21) + D, ain(args, 22) + D, args.out, F.G == 256 ? (const float*)(wsl(ws) + WS_H) : nullptr, 1.f / (H8_SCALE * WD8_SCALE));
#endif
        }
        if (l == 1) SEAM(pb + 10);
    }
#undef IN
#undef SEAM
#undef XB
#undef PROJ
#undef U2
#undef Qb
#undef Kb
#undef Vb
#undef YCAT
#undef YG
#undef Ebuf
#undef HGU
#undef HGS
#undef HGG
#undef lbl
#undef rstdq
#undef rstdkv
#undef rope
#undef PRE
#undef R0
#undef R1
#undef TIDX
#undef TW
#undef POS
#undef CNT
}
}
#ifndef MK_LAUNCHES
#define MK_LAUNCHES 1
#endif
extern "C" void kernel_launch(void* const* d_in, const int* in_sizes, int n_in, void* d_out, int out_size, void* d_ws, size_t ws_size, hipStream_t stream) {
    (void)in_sizes; (void)out_size;
    using namespace mk;
    static int grid = 0;
    if (!grid) {
        int dev = 0, cus = 0; (void)hipGetDevice(&dev); (void)hipDeviceGetAttribute(&cus, hipDeviceAttributeMultiprocessorCount, dev);
        if (hipFuncSetAttribute((const void*)mk_fwd, hipFuncAttributeMaxDynamicSharedMemorySize, LDS_BYTES) != hipSuccess) fprintf(stderr, "kernel_launch: hipFuncSetAttribute(%d B LDS) failed\n", LDS_BYTES);
        int per_cu = 0; (void)hipOccupancyMaxActiveBlocksPerMultiprocessor(&per_cu, (const void*)mk_fwd, NWAVES * 64, LDS_BYTES); (void)hipGetLastError();
        if (per_cu < 1) fprintf(stderr, "kernel_launch: occupancy query reports %d blocks per CU\n", per_cu);
        grid = cus > 0 ? cus : 256;
    }
    if (n_in != 30 || ws_size < WS_END) { fprintf(stderr, "kernel_launch: need 30 inputs and %zu bytes of workspace (got %d, %zu)\n", (size_t)WS_END, n_in, ws_size); return; }
    unsigned char* ws = (unsigned char*)d_ws;
    (void)hipMemsetAsync(ws + WS_CTL, 0, CTL_ZERO_BYTES, stream);
    Args a{}; for (int i = 0; i < 30; ++i) a.in[i] = (const float*)d_in[i]; a.out = (float*)d_out; a.ws = ws; a.prep_mask = 255;
    constexpr int NPH = 2 + 2 * NPH_L;
    if (MK_LAUNCHES == 1) { a.ph_lo = 0; a.ph_hi = NPH; a.li = 0; hipLaunchKernelGGL(mk_fwd, dim3(grid), dim3(NWAVES * 64), LDS_BYTES, stream, a); }
    else for (int p = 0; p < NPH; ++p) { a.ph_lo = p; a.ph_hi = p + 1; a.li = 0; hipLaunchKernelGGL(mk_fwd, dim3(grid), dim3(NWAVES * 64), LDS_BYTES, stream, a); }
}
```

```cpp
#include <hip/hip_runtime.h>
#include <cstdio>
#include <cstdint>
#include <cmath>
namespace pg8 {
#define PG8_LAS __attribute__((address_space(3)))
typedef unsigned short bf16_t;
typedef short bf16x8 __attribute__((ext_vector_type(8)));
typedef float f32x4 __attribute__((ext_vector_type(4)));
typedef unsigned u32x4 __attribute__((ext_vector_type(4)));
constexpr int BM = 256, BK = 64, HALF = 128, HTB = HALF * BK * 2  , STAGE_BYTES = 8 * HTB, NXCD = 8, WGM = 8;

__host__ __device__ __forceinline__ int lds_byte(int r, int c) { const int st = (r >> 4) * 2 + (c >> 5), rr = r & 15, cc = c & 31, ob = rr * 64 + cc * 2; return st * 1024 + (ob ^ (((ob >> 9) & 1) << 5)); }
__host__ __device__ __forceinline__ void stage_rc(int b, int& R, int& C) { const int st = b / 1024, sb = b % 1024, swz = sb ^ (((sb >> 9) & 1) << 5); R = (st >> 1) * 16 + swz / 64; C = (st & 1) * 32 + (swz % 64) / 2; }
__host__ __device__ __forceinline__ int perm32(int rho) { const int n = rho >> 4, i = rho & 15; return 8 * (i >> 2) + 4 * n + (i & 3); }

struct Unit { int pm, pn, pa, pb; };
struct Gemm { const bf16_t* A; const bf16_t* Bt; int M, N, K, lda, ldb; };

struct StaticOrder {
    int nM, nN, nwg, G, c;
    __host__ __device__ void init(int M, int N, int G_, int c_) { nM = M / BM; nN = N / BM; nwg = nM * nN; G = G_; c = c_; }
    __host__ __device__ bool next(int i, Unit& u) const {
        const long L = (long)i * G + c; if (L >= nwg) return false;
        int wgid = (int)L; { const int q = nwg / NXCD, r = nwg % NXCD, xcd = wgid % NXCD, off = wgid / NXCD; wgid = (xcd < r ? xcd * (q + 1) : r * (q + 1) + (xcd - r) * q) + off; }
        const int nig = WGM * nN, gid = wgid / nig, fm = gid * WGM, gsz = (nM - fm) < WGM ? (nM - fm) : WGM;
        u.pm = fm + ((wgid % nig) % gsz); u.pn = (wgid % nig) / gsz; u.pa = u.pm; u.pb = u.pn; return true;
    }
    __device__ __forceinline__ void a_ready(const Unit&) const {}
    __device__ __forceinline__ void done(const Unit&) const {}
};


__device__ __forceinline__ unsigned cvt_pk_bf16(float lo, float hi) { unsigned r; asm volatile("v_cvt_pk_bf16_f32 %0, %1, %2" : "=v"(r) : "v"(lo), "v"(hi)); return r; }
typedef float f32x2 __attribute__((ext_vector_type(2)));
template <class Epi, class Sched, bool ALIGN_EPI = false, bool SP2 = false>
__device__ __forceinline__ void gemm_phase(PG8_LAS unsigned char* lds, const Gemm g, const Sched& S, const Epi& E) {
    int tid_ = threadIdx.x; asm volatile("" : "+v"(tid_));
    const int tid = tid_, wid = __builtin_amdgcn_readfirstlane(tid >> 6), lane = tid & 63, wr = wid >> 2, wc = wid & 3, fr = lane & 15, fq = lane >> 4;
    const int K = g.K, nt = K / BK;
    unsigned voffA, voffB;
    { int R, C; stage_rc(tid * 16, R, C); const int Rb = Epi::PERM ? ((R & ~31) + perm32(R & 31)) : R;
        voffA = (unsigned)(R * g.lda + C) * 2u; voffB = (unsigned)(Rb * K + C) * 2u; }
    const size_t rsA = (size_t)64 * g.lda * 2, rsB = (size_t)64 * K * 2;
    const size_t kstep = (size_t)(BK * 2);
    const size_t hstepA = (size_t)HALF * g.lda * 2, hstepB = (size_t)HALF * K * 2;
    const size_t tstepA = 2 * hstepA, tstepB = 2 * hstepB;
    const unsigned ldsw = (unsigned)wid * 1024u;
    const int aoff = lds_byte(wr * 64 + fr, fq * 8), boff = lds_byte(wc * 32 + fr, fq * 8);
#define PG8_SA(b, h) (((b) * 2 + (h)) * HTB)
#define PG8_SB(b, h) ((4 + (b) * 2 + (h)) * HTB)
#define PG8_STAGE(bufoff, gbase, voff) do { _Pragma("unroll") for (int _i = 0; _i < 2; ++_i) \
        __builtin_amdgcn_global_load_lds((const unsigned*)((const char*)(gbase) + (size_t)_i * PG8_RS_##voff + (voff)), (PG8_LAS unsigned*)(lds + (bufoff) + ldsw + _i * 8192), 16, 0, 0); } while (0)
#define PG8_RS_voffA rsA
#define PG8_RS_voffB rsB
#define PG8_LDA(dst, b, h) do { _Pragma("unroll") for (int m = 0; m < 4; ++m) _Pragma("unroll") for (int k = 0; k < 2; ++k) dst[m][k] = *(const PG8_LAS bf16x8*)(lds + PG8_SA(b, h) + aoff + m * 2048 + k * 1024); } while (0)
#define PG8_LDB(dst, b, h) do { _Pragma("unroll") for (int n = 0; n < 2; ++n) _Pragma("unroll") for (int k = 0; k < 2; ++k) dst[n][k] = *(const PG8_LAS bf16x8*)(lds + PG8_SB(b, h) + boff + n * 2048 + k * 1024); } while (0)
#define PG8_MMA(ai, bj, At, Bt) do { __builtin_amdgcn_s_setprio(1); _Pragma("unroll") for (int m = 0; m < 4; ++m) _Pragma("unroll") for (int n = 0; n < 2; ++n) _Pragma("unroll") for (int k = 0; k < 2; ++k) \
        acc[ai][bj][m][n] = __builtin_amdgcn_mfma_f32_16x16x32_bf16(Bt[n][k], At[m][k], acc[ai][bj][m][n], 0, 0, 0); __builtin_amdgcn_s_setprio(0); } while (0)
#define PG8_WAIT_V(n) asm volatile("s_waitcnt vmcnt(" #n ")" ::: "memory")
#define PG8_WAIT_L(n) asm volatile("s_waitcnt lgkmcnt(" #n ")" ::: "memory")
#define PG8_BAR __builtin_amdgcn_s_barrier()
#define PG8_SCHED __builtin_amdgcn_sched_barrier(0)
    Unit cur, nxt; int ui = 0;
    if (!S.next(0, cur)) return;
    f32x4 acc[2][2][4][2];
#pragma unroll
    for (int a = 0; a < 2; ++a)
#pragma unroll
        for (int b = 0; b < 2; ++b)
#pragma unroll
            for (int m = 0; m < 4; ++m)
#pragma unroll
                for (int n = 0; n < 2; ++n) acc[a][b][m][n] = (f32x4){0.f, 0.f, 0.f, 0.f};
    bf16x8 At[4][2], B0[2][2], B1[2][2];
    const char* cA = (const char*)g.A + (size_t)cur.pa * tstepA; const char* cB = (const char*)g.Bt + (size_t)cur.pb * tstepB;
    S.a_ready(cur);
    if constexpr (SP2) {
        PG8_STAGE(PG8_SB(0, 0), cB, voffB); PG8_STAGE(PG8_SB(0, 1), cB + hstepB, voffB); PG8_STAGE(PG8_SA(0, 0), cA, voffA); PG8_STAGE(PG8_SA(0, 1), cA + hstepA, voffA);
        if (wr == 1) PG8_BAR;
        PG8_WAIT_V(2); PG8_BAR;
        PG8_STAGE(PG8_SB(1, 0), cB + kstep, voffB); PG8_STAGE(PG8_SA(1, 0), cA + kstep, voffA); PG8_STAGE(PG8_SB(1, 1), cB + hstepB + kstep, voffB);
        PG8_WAIT_V(6); PG8_BAR;
    } else {
        PG8_STAGE(PG8_SB(0, 0), cB, voffB); PG8_STAGE(PG8_SA(0, 0), cA, voffA); PG8_STAGE(PG8_SB(0, 1), cB + hstepB, voffB); PG8_STAGE(PG8_SA(0, 1), cA + hstepA, voffA);
        if (wr == 1) PG8_BAR;
        PG8_WAIT_V(4); PG8_BAR;
        PG8_STAGE(PG8_SB(1, 0), cB + kstep, voffB); PG8_STAGE(PG8_SA(1, 0), cA + kstep, voffA); PG8_STAGE(PG8_SB(1, 1), cB + hstepB + kstep, voffB);
        PG8_WAIT_V(6); PG8_BAR;
    }
    for (;;) {
        const bool has_next = S.next(ui + 1, nxt);
        const char* nA = has_next ? (const char*)g.A + (size_t)nxt.pa * tstepA : cA; const char* nB = has_next ? (const char*)g.Bt + (size_t)nxt.pb * tstepB : cB;
        for (int t = 0; t < nt; t += 2) {
            const bool last = (t == nt - 2);
            const char* a1 = cA + (size_t)(t + 1) * kstep;
            const char* a2 = last ? nA : cA + (size_t)(t + 2) * kstep; const char* b2 = last ? nB : cB + (size_t)(t + 2) * kstep;
            const char* a3 = a2 + kstep; const char* b3 = b2 + kstep;
            if (last && has_next) S.a_ready(nxt);
            if constexpr (SP2) {
            PG8_LDB(B0, 0, 0); PG8_LDB(B1, 0, 1); PG8_SCHED; PG8_LDA(At, 0, 0); PG8_STAGE(PG8_SA(1, 1), a1 + hstepA, voffA);
            PG8_WAIT_V(8); PG8_WAIT_L(0); PG8_BAR; PG8_MMA(0, 0, At, B0); PG8_MMA(0, 1, At, B1); PG8_BAR; PG8_SCHED;
            PG8_LDA(At, 0, 1); PG8_STAGE(PG8_SB(0, 0), b2, voffB); PG8_STAGE(PG8_SB(0, 1), b2 + hstepB, voffB); PG8_STAGE(PG8_SA(0, 0), a2, voffA);
            PG8_WAIT_V(8); PG8_WAIT_L(0); PG8_BAR; PG8_MMA(1, 0, At, B0); PG8_MMA(1, 1, At, B1); PG8_BAR; PG8_SCHED;
            PG8_LDB(B0, 1, 0); PG8_LDB(B1, 1, 1); PG8_SCHED; PG8_LDA(At, 1, 0); PG8_STAGE(PG8_SA(0, 1), a2 + hstepA, voffA);
            PG8_WAIT_V(8); PG8_WAIT_L(0); PG8_BAR; PG8_MMA(0, 0, At, B0); PG8_MMA(0, 1, At, B1); PG8_BAR; PG8_SCHED;
            PG8_LDA(At, 1, 1); PG8_STAGE(PG8_SB(1, 0), b3, voffB); PG8_STAGE(PG8_SB(1, 1), b3 + hstepB, voffB); PG8_STAGE(PG8_SA(1, 0), a3, voffA);
            PG8_WAIT_V(8); PG8_WAIT_L(0); PG8_BAR; PG8_MMA(1, 0, At, B0); PG8_MMA(1, 1, At, B1); PG8_BAR; PG8_SCHED;
            } else {
            PG8_LDB(B0, 0, 0); PG8_SCHED; PG8_LDA(At, 0, 0); PG8_STAGE(PG8_SA(1, 1), a1 + hstepA, voffA);
            PG8_WAIT_L(8); PG8_BAR; PG8_WAIT_L(0); PG8_MMA(0, 0, At, B0); PG8_BAR; PG8_SCHED;
            PG8_LDB(B1, 0, 1); PG8_STAGE(PG8_SB(0, 0), b2, voffB);
            PG8_BAR; PG8_WAIT_L(0); PG8_MMA(0, 1, At, B1); PG8_BAR;
            PG8_LDA(At, 0, 1); PG8_STAGE(PG8_SA(0, 0), a2, voffA);
            PG8_BAR; PG8_WAIT_L(0); PG8_MMA(1, 0, At, B0); PG8_BAR; PG8_SCHED;
            PG8_STAGE(PG8_SB(0, 1), b2 + hstepB, voffB);
            PG8_WAIT_V(6); PG8_BAR; PG8_MMA(1, 1, At, B1); PG8_BAR;
            PG8_LDB(B0, 1, 0); PG8_SCHED; PG8_LDA(At, 1, 0); PG8_STAGE(PG8_SA(0, 1), a2 + hstepA, voffA);
            PG8_WAIT_L(8); PG8_BAR; PG8_WAIT_L(0); PG8_MMA(0, 0, At, B0); PG8_BAR; PG8_SCHED;
            PG8_LDB(B1, 1, 1); PG8_STAGE(PG8_SB(1, 0), b3, voffB);
            PG8_BAR; PG8_WAIT_L(0); PG8_MMA(0, 1, At, B1); PG8_BAR;
            PG8_LDA(At, 1, 1); PG8_STAGE(PG8_SA(1, 0), a3, voffA);
            PG8_BAR; PG8_WAIT_L(0); PG8_MMA(1, 0, At, B0); PG8_BAR; PG8_SCHED;
            PG8_STAGE(PG8_SB(1, 1), b3 + hstepB, voffB);
            PG8_WAIT_V(6); PG8_BAR; PG8_MMA(1, 1, At, B1); PG8_BAR;
            }
        }
        if constexpr (ALIGN_EPI) { if (wr == 0) PG8_BAR; }
        if constexpr (!Epi::AFTER_DRAIN) { E(acc, cur, wr, wc, fr, fq); S.done(cur); }
        if (!has_next) break;
#pragma unroll
        for (int a = 0; a < 2; ++a)
#pragma unroll
            for (int b = 0; b < 2; ++b)
#pragma unroll
                for (int m = 0; m < 4; ++m)
#pragma unroll
                    for (int n = 0; n < 2; ++n) acc[a][b][m][n] = (f32x4){0.f, 0.f, 0.f, 0.f};
        cur = nxt; cA = nA; cB = nB; ++ui;
        if constexpr (ALIGN_EPI) { if (wr == 1) PG8_BAR; }
    }
    PG8_WAIT_V(0);
    if constexpr (!ALIGN_EPI) { if (wr == 0) PG8_BAR; }
    PG8_BAR;
    if constexpr (Epi::AFTER_DRAIN) { E.fused(acc, cur, wr, wc, fr, fq, lds, wid, lane); S.done(cur); }
#undef PG8_SA
#undef PG8_SB
#undef PG8_STAGE
#undef PG8_RS_voffA
#undef PG8_RS_voffB
#undef PG8_LDA
#undef PG8_LDB
#undef PG8_MMA
#undef PG8_WAIT_V
#undef PG8_WAIT_L
#undef PG8_BAR
#undef PG8_SCHED
}
typedef int i32x4 __attribute__((ext_vector_type(4)));
template <class Epi, class Sched, bool ALIGN_EPI = false, bool SP2 = false>
__device__ __forceinline__ void gemm_phase_i8(PG8_LAS unsigned char* lds, const Gemm g, const Sched& S, const Epi& E) {
    int tid_ = threadIdx.x; asm volatile("" : "+v"(tid_));
    const int tid = tid_, wid = __builtin_amdgcn_readfirstlane(tid >> 6), lane = tid & 63, wr = wid >> 2, wc = wid & 3, fr = lane & 15, fq = lane >> 4;
    const int K = g.K, nt = K / BK;
    unsigned voffA, voffB;
    { int R, C; stage_rc(tid * 16, R, C); const int Rb = Epi::PERM ? ((R & ~31) + perm32(R & 31)) : R;
        voffA = (unsigned)(R * g.lda + C) * 2u; voffB = (unsigned)(Rb * K + C) * 2u; }
    const size_t rsA = (size_t)64 * g.lda * 2, rsB = (size_t)64 * K * 2;
    const size_t kstep = (size_t)(BK * 2);
    const size_t hstepA = (size_t)HALF * g.lda * 2, hstepB = (size_t)HALF * K * 2;
    const size_t tstepA = 2 * hstepA, tstepB = 2 * hstepB;
    const unsigned ldsw = (unsigned)wid * 1024u;
    const int aoff = lds_byte(wr * 64 + fr, fq * 8), boff = lds_byte(wc * 32 + fr, fq * 8);
#define PG8_SA(b, h) (((b) * 2 + (h)) * HTB)
#define PG8_SB(b, h) ((4 + (b) * 2 + (h)) * HTB)
#define PG8_STAGE(bufoff, gbase, voff) do { _Pragma("unroll") for (int _i = 0; _i < 2; ++_i) \
        __builtin_amdgcn_global_load_lds((const unsigned*)((const char*)(gbase) + (size_t)_i * PG8_RS_##voff + (voff)), (PG8_LAS unsigned*)(lds + (bufoff) + ldsw + _i * 8192), 16, 0, 0); } while (0)
#define PG8_RS_voffA rsA
#define PG8_RS_voffB rsB
#define PG8_LDA(dst, b, h) do { _Pragma("unroll") for (int m = 0; m < 4; ++m) _Pragma("unroll") for (int k = 0; k < 2; ++k) dst[m][k] = *(const PG8_LAS bf16x8*)(lds + PG8_SA(b, h) + aoff + m * 2048 + k * 1024); } while (0)
#define PG8_LDB(dst, b, h) do { _Pragma("unroll") for (int n = 0; n < 2; ++n) _Pragma("unroll") for (int k = 0; k < 2; ++k) dst[n][k] = *(const PG8_LAS bf16x8*)(lds + PG8_SB(b, h) + boff + n * 2048 + k * 1024); } while (0)
#define PG8_MMA(ai, bj, At, Bt) do { __builtin_amdgcn_s_setprio(1); _Pragma("unroll") for (int m = 0; m < 4; ++m) _Pragma("unroll") for (int n = 0; n < 2; ++n) _Pragma("unroll") for (int k = 0; k < 2; ++k) \
        acc[ai][bj][m][n] = __builtin_amdgcn_mfma_i32_16x16x64_i8(__builtin_bit_cast(i32x4, Bt[n][k]), __builtin_bit_cast(i32x4, At[m][k]), acc[ai][bj][m][n], 0, 0, 0); __builtin_amdgcn_s_setprio(0); } while (0)
#define PG8_WAIT_V(n) asm volatile("s_waitcnt vmcnt(" #n ")" ::: "memory")
#define PG8_WAIT_L(n) asm volatile("s_waitcnt lgkmcnt(" #n ")" ::: "memory")
#define PG8_BAR __builtin_amdgcn_s_barrier()
#define PG8_SCHED __builtin_amdgcn_sched_barrier(0)
    Unit cur, nxt; int ui = 0;
    if (!S.next(0, cur)) return;
    i32x4 acc[2][2][4][2];
#pragma unroll
    for (int a = 0; a < 2; ++a)
#pragma unroll
        for (int b = 0; b < 2; ++b)
#pragma unroll
            for (int m = 0; m < 4; ++m)
#pragma unroll
                for (int n = 0; n < 2; ++n) acc[a][b][m][n] = (i32x4){0, 0, 0, 0};
    bf16x8 At[4][2], B0[2][2], B1[2][2];
    const char* cA = (const char*)g.A + (size_t)cur.pa * tstepA; const char* cB = (const char*)g.Bt + (size_t)cur.pb * tstepB;
    S.a_ready(cur);
    if constexpr (SP2) {
        PG8_STAGE(PG8_SB(0, 0), cB, voffB); PG8_STAGE(PG8_SB(0, 1), cB + hstepB, voffB); PG8_STAGE(PG8_SA(0, 0), cA, voffA); PG8_STAGE(PG8_SA(0, 1), cA + hstepA, voffA);
        if (wr == 1) PG8_BAR;
        PG8_WAIT_V(2); PG8_BAR;
        PG8_STAGE(PG8_SB(1, 0), cB + kstep, voffB); PG8_STAGE(PG8_SA(1, 0), cA + kstep, voffA); PG8_STAGE(PG8_SB(1, 1), cB + hstepB + kstep, voffB);
        PG8_WAIT_V(6); PG8_BAR;
    } else {
        PG8_STAGE(PG8_SB(0, 0), cB, voffB); PG8_STAGE(PG8_SA(0, 0), cA, voffA); PG8_STAGE(PG8_SB(0, 1), cB + hstepB, voffB); PG8_STAGE(PG8_SA(0, 1), cA + hstepA, voffA);
        if (wr == 1) PG8_BAR;
        PG8_WAIT_V(4); PG8_BAR;
        PG8_STAGE(PG8_SB(1, 0), cB + kstep, voffB); PG8_STAGE(PG8_SA(1, 0), cA + kstep, voffA); PG8_STAGE(PG8_SB(1, 1), cB + hstepB + kstep, voffB);
        PG8_WAIT_V(6); PG8_BAR;
    }
    for (;;) {
        const bool has_next = S.next(ui + 1, nxt);
        const char* nA = has_next ? (const char*)g.A + (size_t)nxt.pa * tstepA : cA; const char* nB = has_next ? (const char*)g.Bt + (size_t)nxt.pb * tstepB : cB;
        for (int t = 0; t < nt; t += 2) {
            const bool last = (t == nt - 2);
            const char* a1 = cA + (size_t)(t + 1) * kstep;
            const char* a2 = last ? nA : cA + (size_t)(t + 2) * kstep; const char* b2 = last ? nB : cB + (size_t)(t + 2) * kstep;
            const char* a3 = a2 + kstep; const char* b3 = b2 + kstep;
            if (last && has_next) S.a_ready(nxt);
            if constexpr (SP2) {
            PG8_LDB(B0, 0, 0); PG8_LDB(B1, 0, 1); PG8_SCHED; PG8_LDA(At, 0, 0); PG8_STAGE(PG8_SA(1, 1), a1 + hstepA, voffA);
            PG8_WAIT_V(8); PG8_WAIT_L(0); PG8_BAR; PG8_MMA(0, 0, At, B0); PG8_MMA(0, 1, At, B1); PG8_BAR; PG8_SCHED;
            PG8_LDA(At, 0, 1); PG8_STAGE(PG8_SB(0, 0), b2, voffB); PG8_STAGE(PG8_SB(0, 1), b2 + hstepB, voffB); PG8_STAGE(PG8_SA(0, 0), a2, voffA);
            PG8_WAIT_V(8); PG8_WAIT_L(0); PG8_BAR; PG8_MMA(1, 0, At, B0); PG8_MMA(1, 1, At, B1); PG8_BAR; PG8_SCHED;
            PG8_LDB(B0, 1, 0); PG8_LDB(B1, 1, 1); PG8_SCHED; PG8_LDA(At, 1, 0); PG8_STAGE(PG8_SA(0, 1), a2 + hstepA, voffA);
            PG8_WAIT_V(8); PG8_WAIT_L(0); PG8_BAR; PG8_MMA(0, 0, At, B0); PG8_MMA(0, 1, At, B1); PG8_BAR; PG8_SCHED;
            PG8_LDA(At, 1, 1); PG8_STAGE(PG8_SB(1, 0), b3, voffB); PG8_STAGE(PG8_SB(1, 1), b3 + hstepB, voffB); PG8_STAGE(PG8_SA(1, 0), a3, voffA);
            PG8_WAIT_V(8); PG8_WAIT_L(0); PG8_BAR; PG8_MMA(1, 0, At, B0); PG8_MMA(1, 1, At, B1); PG8_BAR; PG8_SCHED;
            } else {
            PG8_LDB(B0, 0, 0); PG8_SCHED; PG8_LDA(At, 0, 0); PG8_STAGE(PG8_SA(1, 1), a1 + hstepA, voffA);
            PG8_WAIT_L(8); PG8_BAR; PG8_WAIT_L(0); PG8_MMA(0, 0, At, B0); PG8_BAR; PG8_SCHED;
            PG8_LDB(B1, 0, 1); PG8_STAGE(PG8_SB(0, 0), b2, voffB);
            PG8_BAR; PG8_WAIT_L(0); PG8_MMA(0, 1, At, B1); PG8_BAR;
            PG8_LDA(At, 0, 1); PG8_STAGE(PG8_SA(0, 0), a2, voffA);
            PG8_BAR; PG8_WAIT_L(0); PG8_MMA(1, 0, At, B0); PG8_BAR; PG8_SCHED;
            PG8_STAGE(PG8_SB(0, 1), b2 + hstepB, voffB);
            PG8_WAIT_V(6); PG8_BAR; PG8_MMA(1, 1, At, B1); PG8_BAR;
            PG8_LDB(B0, 1, 0); PG8_SCHED; PG8_LDA(At, 1, 0); PG8_STAGE(PG8_SA(0, 1), a2 + hstepA, voffA);
            PG8_WAIT_L(8); PG8_BAR; PG8_WAIT_L(0); PG8_MMA(0, 0, At, B0); PG8_BAR; PG8_SCHED;
            PG8_LDB(B1, 1, 1); PG8_STAGE(PG8_SB(1, 0), b3, voffB);
            PG8_BAR; PG8_WAIT_L(0); PG8_MMA(0, 1, At, B1); PG8_BAR;
            PG8_LDA(At, 1, 1); PG8_STAGE(PG8_SA(1, 0), a3, voffA);
            PG8_BAR; PG8_WAIT_L(0); PG8_MMA(1, 0, At, B0); PG8_BAR; PG8_SCHED;
            PG8_STAGE(PG8_SB(1, 1), b3 + hstepB, voffB);
            PG8_WAIT_V(6); PG8_BAR; PG8_MMA(1, 1, At, B1); PG8_BAR;
            }
        }
        if constexpr (ALIGN_EPI) { if (wr == 0) PG8_BAR; }
        if constexpr (!Epi::AFTER_DRAIN) { f32x4 accf[2][2][4][2];
#pragma unroll
            for (int a = 0; a < 2; ++a)
#pragma unroll
                for (int b = 0; b < 2; ++b)
#pragma unroll
                    for (int m = 0; m < 4; ++m)
#pragma unroll
                        for (int n = 0; n < 2; ++n) accf[a][b][m][n] = __builtin_convertvector(acc[a][b][m][n], f32x4);
            E(accf, cur, wr, wc, fr, fq); S.done(cur); }
        if (!has_next) break;
#pragma unroll
        for (int a = 0; a < 2; ++a)
#pragma unroll
            for (int b = 0; b < 2; ++b)
#pragma unroll
                for (int m = 0; m < 4; ++m)
#pragma unroll
                    for (int n = 0; n < 2; ++n) acc[a][b][m][n] = (i32x4){0, 0, 0, 0};
        cur = nxt; cA = nA; cB = nB; ++ui;
        if constexpr (ALIGN_EPI) { if (wr == 1) PG8_BAR; }
    }
    PG8_WAIT_V(0);
    if constexpr (!ALIGN_EPI) { if (wr == 0) PG8_BAR; }
    PG8_BAR;
#undef PG8_SA
#undef PG8_SB
#undef PG8_STAGE
#undef PG8_RS_voffA
#undef PG8_RS_voffB
#undef PG8_LDA
#undef PG8_LDB
#undef PG8_MMA
#undef PG8_WAIT_V
#undef PG8_WAIT_L
#undef PG8_BAR
#undef PG8_SCHED
}
typedef int v8i __attribute__((ext_vector_type(8)));
typedef short s16x16 __attribute__((ext_vector_type(16)));
template <class Epi, class Sched, bool ALIGN_EPI = false, bool SP2 = false>
__device__ __forceinline__ void gemm_phase8(PG8_LAS unsigned char* lds, const Gemm g, const Sched& S, const Epi& E) {
    int tid_ = threadIdx.x; asm volatile("" : "+v"(tid_));
    const int tid = tid_, wid = __builtin_amdgcn_readfirstlane(tid >> 6), lane = tid & 63, wr = wid >> 2, wc = wid & 3, fr = lane & 15, fq = lane >> 4;
    const int K = g.K, nt = K / BK;
    int scl_ = 0x7f7f7f7f; asm volatile("" : "+v"(scl_));
    unsigned voffA, voffB;
    { int R, C; stage_rc(tid * 16, R, C); const int Rb = Epi::PERM ? ((R & ~31) + perm32(R & 31)) : R;
        voffA = (unsigned)(R * g.lda + C) * 2u; voffB = (unsigned)(Rb * (g.ldb ? g.ldb : K) + C) * 2u; }
    const int ldb = g.ldb ? g.ldb : K;
    const size_t rsA = (size_t)64 * g.lda * 2, rsB = (size_t)64 * ldb * 2;
    const size_t kstep = (size_t)(BK * 2);
    const size_t hstepA = (size_t)HALF * g.lda * 2, hstepB = (size_t)HALF * ldb * 2;
    const size_t tstepA = 2 * hstepA, tstepB = 2 * hstepB;
    const unsigned ldsw = (unsigned)wid * 1024u;
    const int aoff = lds_byte(wr * 64 + fr, fq * 16), boff = lds_byte(wc * 32 + fr, fq * 16);
#define PG8_SA(b, h) (((b) * 2 + (h)) * HTB)
#define PG8_SB(b, h) ((4 + (b) * 2 + (h)) * HTB)
#define PG8_STAGE(bufoff, gbase, voff) do { _Pragma("unroll") for (int _i = 0; _i < 2; ++_i) \
        __builtin_amdgcn_global_load_lds((const unsigned*)((const char*)(gbase) + (size_t)_i * PG8_RS_##voff + (voff)), (PG8_LAS unsigned*)(lds + (bufoff) + ldsw + _i * 8192), 16, 0, 0); } while (0)
#define PG8_RS_voffA rsA
#define PG8_RS_voffB rsB
#define PG8_LDA(dst, b, h) do { _Pragma("unroll") for (int m = 0; m < 4; ++m) { const bf16x8 lo_ = *(const PG8_LAS bf16x8*)(lds + PG8_SA(b, h) + aoff + m * 2048), hi_ = *(const PG8_LAS bf16x8*)(lds + PG8_SA(b, h) + aoff + m * 2048 + 16); dst[m] = __builtin_bit_cast(v8i, __builtin_shufflevector(lo_, hi_, 0, 1, 2, 3, 4, 5, 6, 7, 8, 9, 10, 11, 12, 13, 14, 15)); } } while (0)
#define PG8_LDB(dst, b, h) do { _Pragma("unroll") for (int n = 0; n < 2; ++n) { const bf16x8 lo_ = *(const PG8_LAS bf16x8*)(lds + PG8_SB(b, h) + boff + n * 2048), hi_ = *(const PG8_LAS bf16x8*)(lds + PG8_SB(b, h) + boff + n * 2048 + 16); dst[n] = __builtin_bit_cast(v8i, __builtin_shufflevector(lo_, hi_, 0, 1, 2, 3, 4, 5, 6, 7, 8, 9, 10, 11, 12, 13, 14, 15)); } } while (0)
#define PG8_MMA(ai, bj, At, Bt) do { __builtin_amdgcn_s_setprio(1); _Pragma("unroll") for (int m = 0; m < 4; ++m) _Pragma("unroll") for (int n = 0; n < 2; ++n) \
        asm volatile("v_mfma_scale_f32_16x16x128_f8f6f4 %0, %1, %2, %0, %3, %3 op_sel_hi:[0,0,0]" : "+v"(acc[ai][bj][m][n]) : "v"(Bt[n]), "v"(At[m]), "v"(scl_)); __builtin_amdgcn_s_setprio(0); } while (0)
#define PG8_WAIT_V(n) asm volatile("s_waitcnt vmcnt(" #n ")" ::: "memory")
#define PG8_WAIT_L(n) asm volatile("s_waitcnt lgkmcnt(" #n ")" ::: "memory")
#define PG8_BAR __builtin_amdgcn_s_barrier()
#define PG8_SCHED __builtin_amdgcn_sched_barrier(0)
    Unit cur, nxt; int ui = 0;
    if (!S.next(0, cur)) return;
    f32x4 acc[2][2][4][2];
#pragma unroll
    for (int a = 0; a < 2; ++a)
#pragma unroll
        for (int b = 0; b < 2; ++b)
#pragma unroll
            for (int m = 0; m < 4; ++m)
#pragma unroll
                for (int n = 0; n < 2; ++n) acc[a][b][m][n] = (f32x4){0.f, 0.f, 0.f, 0.f};
    v8i At[4], B0[2], B1[2];
    const char* cA = (const char*)g.A + (size_t)cur.pa * tstepA; const char* cB = (const char*)g.Bt + (size_t)cur.pb * tstepB;
    S.a_ready(cur);
    if constexpr (SP2) {
        PG8_STAGE(PG8_SB(0, 0), cB, voffB); PG8_STAGE(PG8_SB(0, 1), cB + hstepB, voffB); PG8_STAGE(PG8_SA(0, 0), cA, voffA); PG8_STAGE(PG8_SA(0, 1), cA + hstepA, voffA);
        if (wr == 1) PG8_BAR;
        PG8_WAIT_V(2); PG8_BAR;
        PG8_STAGE(PG8_SB(1, 0), cB + kstep, voffB); PG8_STAGE(PG8_SA(1, 0), cA + kstep, voffA); PG8_STAGE(PG8_SB(1, 1), cB + hstepB + kstep, voffB);
        PG8_WAIT_V(6); PG8_BAR;
    } else {
        PG8_STAGE(PG8_SB(0, 0), cB, voffB); PG8_STAGE(PG8_SA(0, 0), cA, voffA); PG8_STAGE(PG8_SB(0, 1), cB + hstepB, voffB); PG8_STAGE(PG8_SA(0, 1), cA + hstepA, voffA);
        if (wr == 1) PG8_BAR;
        PG8_WAIT_V(4); PG8_BAR;
        PG8_STAGE(PG8_SB(1, 0), cB + kstep, voffB); PG8_STAGE(PG8_SA(1, 0), cA + kstep, voffA); PG8_STAGE(PG8_SB(1, 1), cB + hstepB + kstep, voffB);
        PG8_WAIT_V(6); PG8_BAR;
    }
    for (;;) {
        const bool has_next = S.next(ui + 1, nxt);
        const char* nA = has_next ? (const char*)g.A + (size_t)nxt.pa * tstepA : cA; const char* nB = has_next ? (const char*)g.Bt + (size_t)nxt.pb * tstepB : cB;
        for (int t = 0; t < nt; t += 2) {
            const bool last = (t == nt - 2);
            const char* a1 = cA + (size_t)(t + 1) * kstep;
            const char* a2 = last ? nA : cA + (size_t)(t + 2) * kstep; const char* b2 = last ? nB : cB + (size_t)(t + 2) * kstep;
            const char* a3 = a2 + kstep; const char* b3 = b2 + kstep;
            if (last && has_next) S.a_ready(nxt);
            if constexpr (SP2) {
            PG8_LDB(B0, 0, 0); PG8_LDB(B1, 0, 1); PG8_SCHED; PG8_LDA(At, 0, 0); PG8_STAGE(PG8_SA(1, 1), a1 + hstepA, voffA);
            PG8_WAIT_V(8); PG8_WAIT_L(0); PG8_BAR; PG8_MMA(0, 0, At, B0); PG8_MMA(0, 1, At, B1); PG8_BAR; PG8_SCHED;
            PG8_LDA(At, 0, 1); PG8_STAGE(PG8_SB(0, 0), b2, voffB); PG8_STAGE(PG8_SB(0, 1), b2 + hstepB, voffB); PG8_STAGE(PG8_SA(0, 0), a2, voffA);
            PG8_WAIT_V(8); PG8_WAIT_L(0); PG8_BAR; PG8_MMA(1, 0, At, B0); PG8_MMA(1, 1, At, B1); PG8_BAR; PG8_SCHED;
            PG8_LDB(B0, 1, 0); PG8_LDB(B1, 1, 1); PG8_SCHED; PG8_LDA(At, 1, 0); PG8_STAGE(PG8_SA(0, 1), a2 + hstepA, voffA);
            PG8_WAIT_V(8); PG8_WAIT_L(0); PG8_BAR; PG8_MMA(0, 0, At, B0); PG8_MMA(0, 1, At, B1); PG8_BAR; PG8_SCHED;
            PG8_LDA(At, 1, 1); PG8_STAGE(PG8_SB(1, 0), b3, voffB); PG8_STAGE(PG8_SB(1, 1), b3 + hstepB, voffB); PG8_STAGE(PG8_SA(1, 0), a3, voffA);
            PG8_WAIT_V(8); PG8_WAIT_L(0); PG8_BAR; PG8_MMA(1, 0, At, B0); PG8_MMA(1, 1, At, B1); PG8_BAR; PG8_SCHED;
            } else {
            PG8_LDB(B0, 0, 0); PG8_SCHED; PG8_LDA(At, 0, 0); PG8_STAGE(PG8_SA(1, 1), a1 + hstepA, voffA);
            PG8_WAIT_L(8); PG8_BAR; PG8_WAIT_L(0); PG8_MMA(0, 0, At, B0); PG8_BAR; PG8_SCHED;
            PG8_LDB(B1, 0, 1); PG8_STAGE(PG8_SB(0, 0), b2, voffB);
            PG8_BAR; PG8_WAIT_L(0); PG8_MMA(0, 1, At, B1); PG8_BAR;
            PG8_LDA(At, 0, 1); PG8_STAGE(PG8_SA(0, 0), a2, voffA);
            PG8_BAR; PG8_WAIT_L(0); PG8_MMA(1, 0, At, B0); PG8_BAR; PG8_SCHED;
            PG8_STAGE(PG8_SB(0, 1), b2 + hstepB, voffB);
            PG8_WAIT_V(6); PG8_BAR; PG8_MMA(1, 1, At, B1); PG8_BAR;
            PG8_LDB(B0, 1, 0); PG8_SCHED; PG8_LDA(At, 1, 0); PG8_STAGE(PG8_SA(0, 1), a2 + hstepA, voffA);
            PG8_WAIT_L(8); PG8_BAR; PG8_WAIT_L(0); PG8_MMA(0, 0, At, B0); PG8_BAR; PG8_SCHED;
            PG8_LDB(B1, 1, 1); PG8_STAGE(PG8_SB(1, 0), b3, voffB);
            PG8_BAR; PG8_WAIT_L(0); PG8_MMA(0, 1, At, B1); PG8_BAR;
            PG8_LDA(At, 1, 1); PG8_STAGE(PG8_SA(1, 0), a3, voffA);
            PG8_BAR; PG8_WAIT_L(0); PG8_MMA(1, 0, At, B0); PG8_BAR; PG8_SCHED;
            PG8_STAGE(PG8_SB(1, 1), b3 + hstepB, voffB);
            PG8_WAIT_V(6); PG8_BAR; PG8_MMA(1, 1, At, B1); PG8_BAR;
            }
        }
        if constexpr (ALIGN_EPI) { if (wr == 0) PG8_BAR; }
        asm volatile("s_nop 15\n\ts_nop 15\n\ts_nop 7" ::: "memory");
        if constexpr (!Epi::AFTER_DRAIN) { E(acc, cur, wr, wc, fr, fq); S.done(cur); }
        if (!has_next) break;
#pragma unroll
        for (int a = 0; a < 2; ++a)
#pragma unroll
            for (int b = 0; b < 2; ++b)
#pragma unroll
                for (int m = 0; m < 4; ++m)
#pragma unroll
                    for (int n = 0; n < 2; ++n) acc[a][b][m][n] = (f32x4){0.f, 0.f, 0.f, 0.f};
        cur = nxt; cA = nA; cB = nB; ++ui;
        if constexpr (ALIGN_EPI) { if (wr == 1) PG8_BAR; }
    }
    PG8_WAIT_V(0);
    if constexpr (!ALIGN_EPI) { if (wr == 0) PG8_BAR; }
    PG8_BAR;
    if constexpr (Epi::AFTER_DRAIN) { E.fused(acc, cur, wr, wc, fr, fq, lds, wid, lane); S.done(cur); }
#undef PG8_SA
#undef PG8_SB
#undef PG8_STAGE
#undef PG8_RS_voffA
#undef PG8_RS_voffB
#undef PG8_LDA
#undef PG8_LDB
#undef PG8_MMA
#undef PG8_WAIT_V
#undef PG8_WAIT_L
#undef PG8_BAR
#undef PG8_SCHED
}
}
namespace mk {
constexpr int NWAVES = 8;
constexpr int M = 16384, D = 2048, NPROJ = 3584, INC = 3392, DFF = 5632, DFE = 7168, NE = 8;
constexpr int NH = 8, QKD = 192, HV = 128, QR = 512, KVR = 256;
constexpr int QLD = NH * QKD, VLD = NH * HV;
constexpr int P_U = 0, P_CQ = 512, P_CKV = 1024, P_KR = 1280, P_HQ = 1344, P_HF = 1856, P_HI = 2368, P_HG = 2880;
constexpr float ALPHA = 1.41421356237309515f, LN_EPS = 1e-5f, RMS_EPS = 1e-6f;
constexpr float QSCALE = 0.07216878364870322f * 1.4426950408889634f;

constexpr size_t MiB = 1u << 20;
constexpr size_t WS_CTL = 0, CTL_ZERO_BYTES = 1 * MiB;
constexpr size_t WS_SMALL = 1 * MiB;
constexpr size_t WS_ROPE = 9 * MiB;
constexpr size_t WS_WIN = 13 * MiB, WIN_L = 14 * MiB;
constexpr size_t WS_WOUT = 41 * MiB, WOUT_L = 8 * MiB;
constexpr size_t WS_WGLU = 57 * MiB, WGLU_L = MiB / 2;
constexpr size_t WS_WUQ = 58 * MiB, WUQ_L = 3 * MiB / 2;
constexpr size_t WS_WUKV = 61 * MiB, WUKV_L = 1 * MiB;
constexpr size_t WS_FFNGU = 63 * MiB, WS_FFND = 107 * MiB;
constexpr size_t WS_MOEGU = 129 * MiB, MOEGU_E = 56 * MiB, WS_MOED = 577 * MiB, MOED_E = 28 * MiB;
constexpr size_t WS_S5K = 801 * MiB, S5K_L = 72 * MiB, WS_S5H = 945 * MiB, S5H_L = 16 * MiB;
constexpr size_t WS_XB = 977 * MiB;
constexpr size_t WS_R0 = 1041 * MiB, WS_R1 = 1169 * MiB;
constexpr size_t WS_PROJ = 1297 * MiB;
constexpr size_t WS_Q = 1409 * MiB, WS_K = 1457 * MiB, WS_V = 1505 * MiB;
constexpr size_t WS_YCAT = 1537 * MiB;
constexpr size_t WS_U2 = 1601 * MiB, WS_E = 1619 * MiB, WS_YG = 1627 * MiB;
constexpr size_t WS_HGU = 1643 * MiB, WS_HGS = 1707 * MiB, WS_HGG = 1739 * MiB;
constexpr size_t WS_PRE = 1297 * MiB;
constexpr size_t WS_H = 1425 * MiB;
constexpr size_t WS_HM = 1169 * MiB, WS_XG = 1645 * MiB, WS_OS = 801 * MiB;
constexpr size_t WS_X8 = 353 * MiB;
constexpr size_t WS_XG8 = 385 * MiB;
constexpr size_t WS_S5PW = 453 * MiB;
constexpr float X8_SCALE = 16.f, W8_SCALE = 256.f, H8_SCALE = 8.f, WD8_SCALE = 1024.f;
constexpr float WI8_CLIP = 0.10f, WI8_Q = 127.f / WI8_CLIP, WI8_S = WI8_CLIP / 127.f;
constexpr size_t SM_XS = 1800 * 1024, SM_XGS = 1864 * 1024;
constexpr size_t WS_END = 1792 * MiB;
constexpr size_t SM_RSTDQ = 0, SM_RSTDKV = 64 * 1024, SM_LB = 128 * 1024  , SM_S5LB = 136 * 1024  ,
                 SM_S5BB = 200 * 1024  , SM_TIDX = 1024 * 1024  , SM_TW = 1280 * 1024  ,
                 SM_POS = 1536 * 1024  , SM_CNT = 1792 * 1024  , SM_MISC = 1800 * 1024,
                 SM_S5KC = 2048 * 1024  ;
constexpr int CW_TMO = 0, CW_CODE = 1, CW_BAR = 4096;

constexpr int RING_BYTES = 131072, LDSCTL_OFF = RING_BYTES, MISC_OFF = LDSCTL_OFF + 320, LDS_BYTES = 147456;

#define GAS __attribute__((address_space(1)))
#define LAS __attribute__((address_space(3)))
typedef unsigned short bf16;
typedef unsigned v4u __attribute__((ext_vector_type(4)));
typedef unsigned v2u __attribute__((ext_vector_type(2)));
typedef float f32x4 __attribute__((ext_vector_type(4)));
typedef float f32x16 __attribute__((ext_vector_type(16)));
typedef short bf16x8 __attribute__((ext_vector_type(8)));
typedef short s16x4 __attribute__((ext_vector_type(4)));
typedef GAS unsigned gu32;
#define RLX_AGENT __ATOMIC_RELAXED, __HIP_MEMORY_SCOPE_AGENT
#define LDS_WAIT() asm volatile("s_waitcnt lgkmcnt(0)" ::: "memory")
#define VM_WAIT() asm volatile("s_waitcnt vmcnt(0)" ::: "memory")
__device__ __forceinline__ unsigned f2bf(float f) { unsigned u = __builtin_bit_cast(unsigned, f); return (u + 0x7fffu + ((u >> 16) & 1u)) >> 16; }
__device__ __forceinline__ unsigned pk2(float lo, float hi) { return f2bf(lo) | (f2bf(hi) << 16); }
__device__ __forceinline__ float bf2f(unsigned short b) { return __builtin_bit_cast(float, (unsigned)b << 16); }
__device__ __forceinline__ float bflo(unsigned w) { return __builtin_bit_cast(float, w << 16); }
__device__ __forceinline__ float bfhi(unsigned w) { return __builtin_bit_cast(float, w & 0xffff0000u); }
__device__ __forceinline__ float sigmoidf_(float x) { return __builtin_amdgcn_rcpf(1.f + __expf(-x)); }
__device__ __forceinline__ float siluf_(float x) { return x * __builtin_amdgcn_rcpf(1.f + __expf(-x)); }

#define XB_TMO      128
#define XB_XCNT(j)  (256  + 64 * (j))
#define XB_XSUB(j)  (1280 + 64 * (j))
#define XB_XGEN(j)  (2304 + 64 * (j))
#define XB_TOP      3328
#define XB_TOPGEN   3392
#define XCD_BAR_WORDS 3456
#define XB_SPIN_CAP (1u << 18)
__device__ __forceinline__ unsigned xb_ld(unsigned* p)              { return __hip_atomic_load(p, __ATOMIC_RELAXED, __HIP_MEMORY_SCOPE_AGENT); }
__device__ __forceinline__ unsigned xb_add(unsigned* p, unsigned v) { return __hip_atomic_fetch_add(p, v, __ATOMIC_RELAXED, __HIP_MEMORY_SCOPE_AGENT); }
__device__ __forceinline__ unsigned xb_xcc_id() { return (unsigned)__builtin_amdgcn_s_getreg((3 << 11) | 20) & 0xFu; }
#define XB_SPIN(cond, bar) do { unsigned _sp = 0; while (cond) { __builtin_amdgcn_s_sleep(1); \
    if ((++_sp & 255u) == 0u) { if (xb_ld(&(bar)[XB_TMO])) break; if (_sp > XB_SPIN_CAP) { atomicAdd(&(bar)[XB_TMO], 1u); break; } } } } while (0)
struct XcdBarrier { unsigned* bar; unsigned x; volatile LAS unsigned* st; };
__device__ __forceinline__ XcdBarrier xcd_barrier_post(unsigned* bar, volatile LAS unsigned* st) {
    XcdBarrier b; b.bar = bar; b.x = xb_xcc_id(); b.st = st;
    if (threadIdx.x == 0) (void)xb_add(&bar[XB_XCNT(b.x)], 1u);
    return b;
}
__device__ __forceinline__ void xcd_barrier_complete(unsigned* bar, unsigned x, unsigned& nloc, unsigned& nx) {
    const unsigned G = gridDim.x * gridDim.y * gridDim.z;
    unsigned sum, cnt, mine, sp = 0u;
    for (;;) {
        sum = 0u; cnt = 0u; mine = 0u;
#pragma unroll
        for (unsigned j = 0; j < 16; ++j) { const unsigned c = xb_ld(&bar[XB_XCNT(j)]); sum += c; cnt += (c > 0u) ? 1u : 0u; }
        mine = xb_ld(&bar[XB_XCNT(x)]);
        if (sum == G) break;
        __builtin_amdgcn_s_sleep(1);
        if ((++sp & 255u) == 0u) { if (xb_ld(&bar[XB_TMO])) break; if (sp > XB_SPIN_CAP) { atomicAdd(&bar[XB_TMO], 1u); break; } }
    }
    nloc = mine > 0u ? mine : 1u; nx = cnt > 0u ? cnt : 1u;
}
__device__ __forceinline__ void xcd_barrier(const XcdBarrier& b) {
    asm volatile("s_waitcnt vmcnt(0)" ::: "memory");
    __syncthreads();
    if (threadIdx.x == 0) {
        unsigned* bar = b.bar;
        __builtin_amdgcn_s_waitcnt(0);
        unsigned nloc = b.st[0], nx = b.st[1];
        if (nloc == 0u) { xcd_barrier_complete(bar, b.x, nloc, nx); b.st[0] = nloc; b.st[1] = nx; }
        const unsigned old = xb_add(&bar[XB_XSUB(b.x)], 1u);
        const unsigned gen = old / nloc;
        if (old + 1u == (gen + 1u) * nloc) {
            __builtin_amdgcn_fence(__ATOMIC_RELEASE, "agent");
            asm volatile("s_waitcnt vmcnt(0)" ::: "memory");
            const unsigned og = xb_add(&bar[XB_TOP], 1u);
            const unsigned tg = og / nx;
            if (og + 1u == (tg + 1u) * nx) xb_add(&bar[XB_TOPGEN], 1u);
            else XB_SPIN(xb_ld(&bar[XB_TOPGEN]) == tg, bar);
            __builtin_amdgcn_fence(__ATOMIC_ACQUIRE, "agent");
            xb_add(&bar[XB_XGEN(b.x)], 1u);
            asm volatile("s_waitcnt vmcnt(0)" ::: "memory");
        } else {
            XB_SPIN(xb_ld(&bar[XB_XGEN(b.x)]) == gen, bar);
            __builtin_amdgcn_fence(__ATOMIC_ACQUIRE, "agent");
            asm volatile("s_waitcnt vmcnt(0)" ::: "memory");
        }
    }
    __syncthreads();
}

struct Frame {
    LAS unsigned char* lds;
    volatile LAS unsigned* MISC;
    gu32* ctl;
    int wave, G, gw, NGW;
    unsigned char* ws;
};
__device__ __forceinline__ int opq(int v) { asm volatile("" : "+v"(v)); return v; }
__device__ __forceinline__ int opq_s(int v) { asm volatile("" : "+s"(v)); return v; }
__device__ __forceinline__ float wave_sum(float v) {
#pragma unroll
    for (int o = 1; o < 64; o <<= 1) v += __shfl_xor(v, o);
    return v;
}

template <int MODE> __device__ __forceinline__ int dst_row(int n, int off) {
    if (MODE == 0) return n + off;
    if (MODE == 1) { const int h = n / QKD, d = n % QKD; if (d < 128) return h * 128 + d; const int j = d - 128; return 1024 + (h >> 2) * 256 + ((j >> 5) << 7) + (h & 3) * 32 + (j & 31); }
    if (MODE == 2) return ((n >> 7) << 8) + (n & 127);
    return ((n >> 7) << 8) + 128 + (n & 127);
}
__device__ __forceinline__ void tr_load(f32x4 (&ld)[8], const float* __restrict__ W, int N, int ldw, int item, int lane) {
    const int nblk = N / 32, kb = item / nblk, nb = item % nblk, k0 = 64 * kb, n0 = 32 * nb;
#pragma unroll
    for (int i = 0; i < 8; ++i) ld[i] = *(const GAS f32x4*)(W + (size_t)(k0 + (lane >> 3) + 8 * i) * ldw + n0 + 4 * (lane & 7));
}
template <int MODE> __device__ __forceinline__ void tr_store(const f32x4 (&ld)[8], int K, int N, bf16* __restrict__ WT, int off, const float* __restrict__ kscale, float sc, LAS float* scr, int item, int lane) {
    const int nblk = N / 32, kb = item / nblk, nb = item % nblk, k0 = 64 * kb, n0 = 32 * nb;
#pragma unroll
    for (int i = 0; i < 8; ++i) { const int kk = (lane >> 3) + 8 * i; float s = sc; if (kscale) s *= kscale[k0 + kk]; LAS float* d = scr + kk * 33 + 4 * (lane & 7);
        d[0] = ld[i].x * s; d[1] = ld[i].y * s; d[2] = ld[i].z * s; d[3] = ld[i].w * s; }
    LDS_WAIT(); asm volatile("" ::: "memory");
    const int c = lane & 7;
#pragma unroll
    for (int j = 0; j < 4; ++j) { const int n = (lane >> 3) + 8 * j; const LAS float* s = scr + (8 * c) * 33 + n;
        v4u o; o.x = pk2(s[0 * 33], s[1 * 33]); o.y = pk2(s[2 * 33], s[3 * 33]); o.z = pk2(s[4 * 33], s[5 * 33]); o.w = pk2(s[6 * 33], s[7 * 33]);
        *(GAS v4u*)(WT + (size_t)dst_row<MODE>(n0 + n, off) * K + k0 + 8 * c) = o; }
    LDS_WAIT(); asm volatile("" ::: "memory");
}
template <int MODE> __device__ __forceinline__ void transpose_job(Frame& F, const float* W, int K, int N, int ldw, bf16* WT, int off, const float* kscale, float sc) {
    LAS float* scr = (LAS float*)(F.lds + F.wave * 16384);
    const int nitems = (K / 64) * (N / 32), lane = (opq((int)threadIdx.x) & 63);
    int it = opq_s(F.gw); if (it >= nitems) return;
    f32x4 ld[8], nx[8]; tr_load(ld, W, N, ldw, it, lane);
    for (; it < nitems; it += F.NGW) {
        const int itn = (it + F.NGW < nitems) ? it + F.NGW : it; tr_load(nx, W, N, ldw, itn, lane);
        tr_store<MODE>(ld, K, N, WT, off, kscale, sc, scr, it, lane);
#pragma unroll
        for (int i = 0; i < 8; ++i) ld[i] = nx[i]; }
}
__device__ __forceinline__ unsigned pk4_fp8(float a, float b, float c, float d) { int w = 0; w = __builtin_amdgcn_cvt_pk_fp8_f32(a, b, w, false); w = __builtin_amdgcn_cvt_pk_fp8_f32(c, d, w, true); return (unsigned)w; }
__device__ __forceinline__ unsigned pk4_i8(float a, float b, float c, float d) {
    const int ia = (int)rintf(__builtin_amdgcn_fmed3f(a, -127.f, 127.f)), ib = (int)rintf(__builtin_amdgcn_fmed3f(b, -127.f, 127.f)), ic = (int)rintf(__builtin_amdgcn_fmed3f(c, -127.f, 127.f)), id = (int)rintf(__builtin_amdgcn_fmed3f(d, -127.f, 127.f));
    return (unsigned)(ia & 255) | ((unsigned)(ib & 255) << 8) | ((unsigned)(ic & 255) << 16) | ((unsigned)id << 24);
}
__device__ __forceinline__ float wave_max(float v) {
#pragma unroll
    for (int o = 1; o < 64; o <<= 1) v = fmaxf(v, __shfl_xor(v, o));
    return v;
}
template <int MODE, bool I8> __device__ __forceinline__ void tr_store8(const f32x4 (&ld)[8], int K, int N, unsigned char* __restrict__ WT, float sc, LAS float* scr, int item, int lane) {
    const int nblk = N / 32, kb = item / nblk, nb = item % nblk, k0 = 64 * kb, n0 = 32 * nb;
#pragma unroll
    for (int i = 0; i < 8; ++i) { const int kk = (lane >> 3) + 8 * i; LAS float* d = scr + kk * 33 + 4 * (lane & 7); d[0] = ld[i].x * sc; d[1] = ld[i].y * sc; d[2] = ld[i].z * sc; d[3] = ld[i].w * sc; }
    LDS_WAIT(); asm volatile("" ::: "memory");
#pragma unroll
    for (int ps = 0; ps < 2; ++ps) { const int n = (lane >> 2) + 16 * ps, c = lane & 3; const LAS float* s = scr + (16 * c) * 33 + n;
        v4u o;
        if (I8) { o.x = pk4_i8(s[0 * 33], s[1 * 33], s[2 * 33], s[3 * 33]); o.y = pk4_i8(s[4 * 33], s[5 * 33], s[6 * 33], s[7 * 33]); o.z = pk4_i8(s[8 * 33], s[9 * 33], s[10 * 33], s[11 * 33]); o.w = pk4_i8(s[12 * 33], s[13 * 33], s[14 * 33], s[15 * 33]); }
        else { o.x = pk4_fp8(s[0 * 33], s[1 * 33], s[2 * 33], s[3 * 33]); o.y = pk4_fp8(s[4 * 33], s[5 * 33], s[6 * 33], s[7 * 33]); o.z = pk4_fp8(s[8 * 33], s[9 * 33], s[10 * 33], s[11 * 33]); o.w = pk4_fp8(s[12 * 33], s[13 * 33], s[14 * 33], s[15 * 33]); }
        *(GAS v4u*)(WT + (size_t)dst_row<MODE>(n0 + n, 0) * K + k0 + 16 * c) = o; }
    LDS_WAIT(); asm volatile("" ::: "memory");
}
template <int MODE> __device__ __forceinline__ void transpose_item8(const float* __restrict__ W, int K, int N, int ldw, unsigned char* __restrict__ WT, float sc, LAS float* scr, int item, int lane) {
    f32x4 ld[8]; tr_load(ld, W, N, ldw, item, lane); tr_store8<MODE, false>(ld, K, N, WT, sc, scr, item, lane);
}
template <int MODE, bool I8> __device__ __forceinline__ void transpose_job8(Frame& F, const float* W, int K, int N, int ldw, unsigned char* WT, float sc) {
    LAS float* scr = (LAS float*)(F.lds + F.wave * 16384);
    const int nitems = (K / 64) * (N / 32), lane = (opq((int)threadIdx.x) & 63);
    int it = opq_s(F.gw); if (it >= nitems) return;
    f32x4 ld[8], nx[8]; tr_load(ld, W, N, ldw, it, lane);
    for (; it < nitems; it += F.NGW) {
        const int itn = (it + F.NGW < nitems) ? it + F.NGW : it; tr_load(nx, W, N, ldw, itn, lane);
        tr_store8<MODE, I8>(ld, K, N, WT, sc, scr, it, lane);
#pragma unroll
        for (int i = 0; i < 8; ++i) ld[i] = nx[i]; }
}
__device__ __forceinline__ void quant_rows_job(Frame& F, const float* __restrict__ src, unsigned char* __restrict__ X8, float* __restrict__ XS, int rows) {
    const int lane = (opq((int)threadIdx.x) & 63);
    for (int t = opq_s(F.gw); t < rows; t += F.NGW) {
        f32x4 v[8]; float am = 0.f;
#pragma unroll
        for (int j = 0; j < 8; ++j) { v[j] = *(const GAS f32x4*)(src + (size_t)t * D + (j * 64 + lane) * 4); am = fmaxf(am, fmaxf(fmaxf(fabsf(v[j].x), fabsf(v[j].y)), fmaxf(fabsf(v[j].z), fabsf(v[j].w)))); }
        am = fmaxf(wave_max(am), 1e-20f); const float q = 127.f / am; if (lane == 0) XS[t] = am * (1.f / 127.f);
#pragma unroll
        for (int j = 0; j < 8; ++j) *(GAS unsigned*)(X8 + (size_t)t * D + (j * 64 + lane) * 4) = pk4_i8(v[j].x * q, v[j].y * q, v[j].z * q, v[j].w * q);
    }
}
__device__ __forceinline__ void cvt_job(Frame& F, const float* __restrict__ src, bf16* __restrict__ dst, size_t n) {
    const size_t nth = (size_t)F.NGW * 64, t0 = (size_t)opq_s(F.gw) * 64 + (opq((int)threadIdx.x) & 63);
    for (size_t i = t0; i < n / 8; i += nth) { const f32x4 a = *(const GAS f32x4*)(src + i * 8), b = *(const GAS f32x4*)(src + i * 8 + 4);
        v4u o; o.x = pk2(a.x, a.y); o.y = pk2(a.z, a.w); o.z = pk2(b.x, b.y); o.w = pk2(b.z, b.w); *(GAS v4u*)(dst + i * 8) = o; }
}
__device__ __forceinline__ void zero_job(Frame& F, void* dst, size_t bytes) {
    const size_t nth = (size_t)F.NGW * 64, t0 = (size_t)opq_s(F.gw) * 64 + (opq((int)threadIdx.x) & 63); const unsigned zz = (unsigned)opq(0); const v4u z = {zz, zz, zz, zz};
    for (size_t i = t0; i < bytes / 16; i += nth) ((GAS v4u*)dst)[i] = z;
}

struct EpiProj {
    static constexpr bool PERM = true, AFTER_DRAIN = false;
    bf16* P; bf16* U2; float sc; const float* rs;
    __device__ __forceinline__ void operator()(const pg8::f32x4 (&acc)[2][2][4][2], const pg8::Unit& u, int wr, int wc, int fr, int fq) const {
        { const int ln_ = opq((int)threadIdx.x) & 63; fr = ln_ & 15; fq = ln_ >> 4; }
        float rsv[8];
#pragma unroll
        for (int k = 0; k < 8; ++k) rsv[k] = rs[u.pm * 256 + (k >> 2) * 128 + wr * 64 + (k & 3) * 16 + fr];
#pragma unroll
        for (int ai = 0; ai < 2; ++ai)
#pragma unroll
            for (int m = 0; m < 4; ++m) { const int row = u.pm * 256 + ai * 128 + wr * 64 + m * 16 + fr; const float s1 = sc * rsv[ai * 4 + m];
#pragma unroll
                for (int bj = 0; bj < 2; ++bj) { const pg8::f32x4 v0 = acc[ai][bj][m][0] * s1, v1 = acc[ai][bj][m][1] * s1;
                    v4u w; w.x = pg8::cvt_pk_bf16(v0[0], v0[1]); w.y = pg8::cvt_pk_bf16(v0[2], v0[3]); w.z = pg8::cvt_pk_bf16(v1[0], v1[1]); w.w = pg8::cvt_pk_bf16(v1[2], v1[3]);
                    const int col = u.pn * 256 + bj * 128 + wc * 32 + 8 * fq;
                    if (u.pn < 2) { const int g = col >> 4, cc = col & 15, chunk = row >> 6, s = row & 63; *(GAS v4u*)(U2 + ((size_t)(g * 256 + chunk) * 1152 + s * 16 + cc)) = w; }
                    else *(GAS v4u*)(P + (size_t)row * NPROJ + col) = w; } }
    }
};
template <bool KV> struct EpiRS {
    static constexpr bool PERM = true, AFTER_DRAIN = false;
    bf16* O1; unsigned char* K8; unsigned char* V8; const float* rstd;
    __device__ __forceinline__ void operator()(const pg8::f32x4 (&acc)[2][2][4][2], const pg8::Unit& u, int wr, int wc, int fr, int fq) const {
        { const int ln_ = opq((int)threadIdx.x) & 63; fr = ln_ & 15; fq = ln_ >> 4; }
        float rsv[8];
#pragma unroll
        for (int k = 0; k < 8; ++k) rsv[k] = rstd[u.pm * 256 + (k >> 2) * 128 + wr * 64 + (k & 3) * 16 + fr];
#pragma unroll
        for (int ai = 0; ai < 2; ++ai)
#pragma unroll
            for (int m = 0; m < 4; ++m) { const int row = u.pm * 256 + ai * 128 + wr * 64 + m * 16 + fr; const float rs = KV ? rsv[ai * 4 + m] * 16.f : rsv[ai * 4 + m];
#pragma unroll
                for (int bj = 0; bj < 2; ++bj) { const pg8::f32x4 v0 = acc[ai][bj][m][0] * rs, v1 = acc[ai][bj][m][1] * rs;
                    if (!KV) { v4u w; w.x = pg8::cvt_pk_bf16(v0[0], v0[1]); w.y = pg8::cvt_pk_bf16(v0[2], v0[3]); w.z = pg8::cvt_pk_bf16(v1[0], v1[1]); w.w = pg8::cvt_pk_bf16(v1[2], v1[3]);
                        *(GAS v4u*)(O1 + (size_t)row * QLD + u.pn * 256 + bj * 128 + wc * 32 + 8 * fq) = w; }
                    else { v2u w; w.x = pk4_fp8(v0[0], v0[1], v0[2], v0[3]); w.y = pk4_fp8(v1[0], v1[1], v1[2], v1[3]);
                        if (bj == 0) *(GAS v2u*)(K8 + (size_t)row * QLD + u.pn * QKD + wc * 32 + 8 * fq) = w;
                        else *(GAS v2u*)(V8 + (size_t)row * VLD + u.pn * HV + wc * 32 + 8 * fq) = w; } }
                asm volatile("" ::: "memory"); }
    }
};

__device__ __forceinline__ void thin_mla(Frame& F, const bf16* __restrict__ P, float* __restrict__ rq, float* __restrict__ rkv, unsigned char* __restrict__ Kb, const float2* __restrict__ rope) {
    const int lane = (opq((int)threadIdx.x) & 63), gw0 = opq_s(F.gw);
    for (int tb = gw0; tb < M; tb += 4 * F.NGW) {
        v4u a[4], b[4]; unsigned short k1[4], k2[4]; float2 cs[4];
#pragma unroll
        for (int k = 0; k < 4; ++k) { const int t = tb + k * F.NGW; if (t < M) { const bf16* p = P + (size_t)t * NPROJ;
            a[k] = *(const GAS v4u*)(p + P_CQ + lane * 8);
            if (lane < 32) { b[k] = *(const GAS v4u*)(p + P_CKV + lane * 8); k1[k] = *(const GAS unsigned short*)(p + P_KR + lane); k2[k] = *(const GAS unsigned short*)(p + P_KR + 32 + lane); cs[k] = rope[(size_t)t * 32 + lane]; } } }
#pragma unroll
        for (int k = 0; k < 4; ++k) { const int t = tb + k * F.NGW; if (t < M) {
            float s = 0.f;
            { const unsigned w[4] = {a[k].x, a[k].y, a[k].z, a[k].w};
#pragma unroll
              for (int i = 0; i < 4; ++i) { const float lo = bflo(w[i]), hi = bfhi(w[i]); s += lo * lo + hi * hi; } }
            float s2 = 0.f;
            if (lane < 32) { const unsigned w[4] = {b[k].x, b[k].y, b[k].z, b[k].w};
#pragma unroll
              for (int i = 0; i < 4; ++i) { const float lo = bflo(w[i]), hi = bfhi(w[i]); s2 += lo * lo + hi * hi; } }
            s = wave_sum(s); s2 = wave_sum(s2);
            if (lane == 0) { rq[t] = rsqrtf(s * (1.f / QR) + RMS_EPS); rkv[t] = rsqrtf(s2 * (1.f / KVR) + RMS_EPS); }
            if (lane < 32) { const float x1 = __uint_as_float((unsigned)k1[k] << 16), x2 = __uint_as_float((unsigned)k2[k] << 16);
                const unsigned yy = pk4_fp8((x1 * cs[k].x - x2 * cs[k].y) * 16.f, (x1 * cs[k].y + x2 * cs[k].x) * 16.f, 0.f, 0.f); const unsigned char y1 = (unsigned char)(yy & 255u), y2 = (unsigned char)((yy >> 8) & 255u);
#pragma unroll
                for (int h = 0; h < NH; ++h) { unsigned char* kp = Kb + (size_t)t * QLD + h * QKD + 128; kp[32 * (lane >> 4) + (lane & 15)] = y1; kp[32 * (lane >> 4) + 16 + (lane & 15)] = y2; } } } }
    }
}
namespace at {
constexpr int KROW = 400, SHM_K = 64 * KROW, SHM_V = 64 * 128 * 2;
constexpr int OFF_V = 0, OFF_K = 3 * SHM_V, OFF_WS = OFF_K + 2 * SHM_K, LDS_NEED = OFF_WS + 8 * 256;
constexpr float THR = 8.f;
__device__ __forceinline__ int v_st(int k, int c) { const int kk = (k & ~0xC) | ((k & 4) << 1) | ((k & 8) >> 1); return ((kk >> 3) * 4 + (c >> 5)) * 512 + ((kk & 7) * 32 + (c & 31)) * 2; }
__device__ __forceinline__ int v_rd_base(int lane) { return ((lane & 3) << 3) | (((lane >> 2) & 3) << 6) | (((lane >> 4) & 1) << 5) | (((lane >> 5) & 1) << 8); }
constexpr int v_rd_off(int d0, int ks, int half) { return d0 * 512 + ks * 4096 + half * 2048; }
__device__ __forceinline__ int crow(int r, int hi) { return (r & 3) + 8 * (r >> 2) + 4 * hi; }
__device__ __forceinline__ unsigned cvtpk(float lo, float hi) { unsigned r; asm volatile("v_cvt_pk_bf16_f32 %0, %1, %2" : "=v"(r) : "v"(lo), "v"(hi)); return r; }
__device__ __forceinline__ void mask_tile(f32x16& p0, f32x16& p1, int dq) {
    const float NEG = -__builtin_inff();
#pragma unroll
    for (int r = 0; r < 16; ++r) { const int c = (r & 3) + 8 * (r >> 2); if (dq - c < 0) p0[r] = NEG; if (dq - c - 32 < 0) p1[r] = NEG; }
}
__device__ __forceinline__ void qkt(f32x16& p0, f32x16& p1, const LAS char* kb, const bf16x8* qr, float negm) {
    const int ka = (int)(unsigned)(uintptr_t)kb;
#define KRD(dst, off) asm volatile("ds_read_b128 %0, %1 offset:%2" : "=&v"(dst) : "v"(ka), "i"(off) : "memory")
#define KW(n) asm volatile("s_waitcnt lgkmcnt(" #n ")" ::: "memory")
#define QK2(x0, x1, d0) do { __builtin_amdgcn_sched_barrier(0); p0 = __builtin_amdgcn_mfma_f32_32x32x16_bf16(x0, qr[d0], p0, 0, 0, 0); p1 = __builtin_amdgcn_mfma_f32_32x32x16_bf16(x1, qr[d0], p1, 0, 0, 0); __builtin_amdgcn_sched_barrier(0); } while (0)
    bf16x8 a0, a1, b0, b1, c0, c1;
    KRD(a0, 0); KRD(a1, 32 * KROW); KRD(b0, 32); KRD(b1, 32 * KROW + 32);
    { float z_ = negm; asm volatile("" : "+v"(z_));
#pragma unroll
      for (int r = 0; r < 16; ++r) { p0[r] = z_; p1[r] = z_; } }
    __builtin_amdgcn_s_setprio(1);
    KRD(c0, 64);  KRD(c1, 32 * KROW + 64);  KW(4); QK2(a0, a1, 0);
    KRD(a0, 96);  KRD(a1, 32 * KROW + 96);  KW(4); QK2(b0, b1, 1);
    KRD(b0, 128); KRD(b1, 32 * KROW + 128); KW(4); QK2(c0, c1, 2);
    KRD(c0, 160); KRD(c1, 32 * KROW + 160); KW(4); QK2(a0, a1, 3);
    KRD(a0, 192); KRD(a1, 32 * KROW + 192); KW(4); QK2(b0, b1, 4);
    KRD(b0, 224); KRD(b1, 32 * KROW + 224); KW(4); QK2(c0, c1, 5);
    KRD(c0, 256); KRD(c1, 32 * KROW + 256); KW(4); QK2(a0, a1, 6);
    KRD(a0, 288); KRD(a1, 32 * KROW + 288); KW(4); QK2(b0, b1, 7);
    KRD(b0, 320); KRD(b1, 32 * KROW + 320); KW(4); QK2(c0, c1, 8);
    KRD(c0, 352); KRD(c1, 32 * KROW + 352); KW(4); QK2(a0, a1, 9);
    KW(2); QK2(b0, b1, 10);
    KW(0); QK2(c0, c1, 11);
    __builtin_amdgcn_s_setprio(0);
#undef KRD
#undef KW
#undef QK2
}
__device__ __forceinline__ void pv_tile(f32x16* o, int vb0, bf16x8 pa0, bf16x8 pa1, bf16x8 pa2, bf16x8 pa3) {
#define TRRD(dst, off) asm volatile("ds_read_b64_tr_b16 %0, %1 offset:%2" : "=&v"(dst) : "v"(vb0), "i"(off) : "memory")
#define PV_D0(d0) do { s16x4 l0, l1, l2, l3, h0, h1, h2, h3; constexpr int b_ = OFF_V + v_rd_off(d0, 0, 0); \
        TRRD(l0, b_); TRRD(h0, b_ + 2048); TRRD(l1, b_ + 4096); TRRD(h1, b_ + 6144); TRRD(l2, b_ + 8192); TRRD(h2, b_ + 10240); TRRD(l3, b_ + 12288); TRRD(h3, b_ + 14336); \
        asm volatile("s_waitcnt lgkmcnt(0)" ::: "memory"); __builtin_amdgcn_sched_barrier(0); \
        o[d0] = __builtin_amdgcn_mfma_f32_32x32x16_bf16(pa0, (bf16x8){l0[0], l0[1], l0[2], l0[3], h0[0], h0[1], h0[2], h0[3]}, o[d0], 0, 0, 0); \
        o[d0] = __builtin_amdgcn_mfma_f32_32x32x16_bf16(pa1, (bf16x8){l1[0], l1[1], l1[2], l1[3], h1[0], h1[1], h1[2], h1[3]}, o[d0], 0, 0, 0); \
        o[d0] = __builtin_amdgcn_mfma_f32_32x32x16_bf16(pa2, (bf16x8){l2[0], l2[1], l2[2], l2[3], h2[0], h2[1], h2[2], h2[3]}, o[d0], 0, 0, 0); \
        o[d0] = __builtin_amdgcn_mfma_f32_32x32x16_bf16(pa3, (bf16x8){l3[0], l3[1], l3[2], l3[3], h3[0], h3[1], h3[2], h3[3]}, o[d0], 0, 0, 0); } while (0)
    __builtin_amdgcn_s_setprio(1); PV_D0(0); PV_D0(1); PV_D0(2); PV_D0(3); __builtin_amdgcn_s_setprio(0);
#undef PV_D0
#undef TRRD
}
__device__ __forceinline__ void attn_unit(int h, int qb, const bf16* __restrict__ Q, const bf16* __restrict__ Kg, const bf16* __restrict__ Vg, const float2* __restrict__ rope, bf16* __restrict__ Y, int yld, int ycol0, LAS char* lds) {
    int tid_ = threadIdx.x; asm volatile("" : "+v"(tid_));
    const int tid = tid_, wid = __builtin_amdgcn_readfirstlane(tid >> 6), lane = tid & 63, r32 = lane & 31, hi = lane >> 5;
    const int NT = 4 * (qb + 1);
    const int q0 = qb * 256, qlo = q0 + wid * 32, qm = qlo + r32 - 4 * hi;
    LAS float* wsf = (LAS float*)(lds + OFF_WS) + wid * 64; LAS float* li_l = wsf; LAS float* al_l = wsf + 32;
    int krow[3], kch[3];
#pragma unroll
    for (int j = 0; j < 3; ++j) { const int id = tid + 512 * j; krow[j] = id / 24; kch[j] = id % 24; }
    const int sr = tid >> 4, sc = (tid & 15) * 8, vst0 = v_st(sr, sc), vst1 = v_st(32 + sr, sc);
    const bf16* Kh = Kg + h * QKD; const bf16* Vh = Vg + h * HV;
    v4u stK[3], stV[2];
#define A_LOAD(t) do { const int k0_ = (t) * 64; _Pragma("unroll") for (int j = 0; j < 3; ++j) stK[j] = *(const GAS v4u*)(Kh + (size_t)(k0_ + krow[j]) * QLD + kch[j] * 8); \
        stV[0] = *(const GAS v4u*)(Vh + (size_t)(k0_ + sr) * VLD + sc); stV[1] = *(const GAS v4u*)(Vh + (size_t)(k0_ + 32 + sr) * VLD + sc); } while (0)
#define A_WRITE(kbf, vbf) do { _Pragma("unroll") for (int j = 0; j < 3; ++j) *(LAS v4u*)(lds + OFF_K + (kbf) * SHM_K + krow[j] * KROW + kch[j] * 16) = stK[j]; \
        *(LAS v4u*)(lds + OFF_V + (vbf) * SHM_V + vst0) = stV[0]; *(LAS v4u*)(lds + OFF_V + (vbf) * SHM_V + vst1) = stV[1]; } while (0)
    A_LOAD(0);
    bf16x8 qr[12];
#pragma unroll
    for (int d0 = 0; d0 < 12; ++d0) qr[d0] = *(const GAS bf16x8*)(Q + (size_t)(qlo + r32) * QLD + h * QKD + d0 * 16 + hi * 8);
    VM_WAIT(); A_WRITE(0, 0);
    { const float2* cs = rope + (size_t)(qlo + r32) * 32 + hi * 8;
#pragma unroll
      for (int f = 0; f < 2; ++f) { v4u x1 = __builtin_bit_cast(v4u, qr[8 + f]), x2 = __builtin_bit_cast(v4u, qr[10 + f]); unsigned* a1 = (unsigned*)&x1; unsigned* a2 = (unsigned*)&x2;
#pragma unroll
          for (int w = 0; w < 4; ++w) { const f32x4 c2 = *(const GAS f32x4*)(cs + f * 16 + 2 * w);
              const float l1 = bflo(a1[w]), h1 = bfhi(a1[w]), l2 = bflo(a2[w]), h2 = bfhi(a2[w]);
              a1[w] = cvtpk(l1 * c2.x - l2 * c2.y, h1 * c2.z - h2 * c2.w); a2[w] = cvtpk(l1 * c2.y + l2 * c2.x, h1 * c2.w + h2 * c2.z); }
          qr[8 + f] = __builtin_bit_cast(bf16x8, x1); qr[10 + f] = __builtin_bit_cast(bf16x8, x2); } }
    __syncthreads();
    float m_reg = 0.f, l_reg = 0.f; f32x16 o[4];
    { float z_ = 0.f; asm volatile("" : "+v"(z_));
#pragma unroll
      for (int d_ = 0; d_ < 4; ++d_)
#pragma unroll
          for (int r = 0; r < 16; ++r) o[d_][r] = z_; }
    const LAS char* kbase = lds + OFF_K + r32 * KROW + hi * 16;
    const int vb0 = (int)(unsigned)(uintptr_t)lds + v_rd_base(lane);
#define PK4(P, B_, OUT) do { unsigned a0 = cvtpk(P[B_+0], P[B_+1]), a1 = cvtpk(P[B_+2], P[B_+3]), b0 = cvtpk(P[B_+4], P[B_+5]), b1 = cvtpk(P[B_+6], P[B_+7]); \
        auto r0 = __builtin_amdgcn_permlane32_swap(a0, b0, false, false); auto r1 = __builtin_amdgcn_permlane32_swap(a1, b1, false, false); \
        v4u w = {r0[0], r1[0], r0[1], r1[1]}; OUT = __builtin_bit_cast(bf16x8, w); } while (0)
    constexpr bool stag = false;
    bf16x8 pa0, pa1, pa2, pa3; pa0 = pa1 = pa2 = pa3 = (bf16x8){0, 0, 0, 0, 0, 0, 0, 0};
    int vcur = 0, vprev = 2;
    for (int t = 0; t <= NT; ++t) {
        if (t + 1 < NT) A_LOAD(t + 1);
        if (stag && t > 0) pv_tile(o, vb0 + vprev * SHM_V, pa0, pa1, pa2, pa3);
        if (t < NT) {
            f32x16 p0, p1; qkt(p0, p1, kbase + (t & 1) * SHM_K, qr, -m_reg);
            { const int kb_ = t * 64; if (kb_ + 63 > qlo) mask_tile(p0, p1, qm - kb_); }
            float pmax = p0[0];
#pragma unroll
            for (int r = 1; r < 16; ++r) pmax = fmaxf(pmax, p0[r]);
#pragma unroll
            for (int r = 0; r < 16; ++r) pmax = fmaxf(pmax, p1[r]);
            { auto rr = __builtin_amdgcn_permlane32_swap(__float_as_uint(pmax), __float_as_uint(pmax), false, false); pmax = fmaxf(__uint_as_float(rr[0]), __uint_as_float(rr[1])); }
            float alpha = 1.f;
            if (!__all(pmax <= THR)) {
                const float dm = fmaxf(pmax, 0.f); alpha = __builtin_amdgcn_exp2f(-dm); m_reg += dm;
#pragma unroll
                for (int r = 0; r < 16; ++r) { p0[r] -= dm; p1[r] -= dm; } }
#pragma unroll
            for (int r = 0; r < 16; ++r) { p0[r] = __builtin_amdgcn_exp2f(p0[r]); p1[r] = __builtin_amdgcn_exp2f(p1[r]); }
            typedef float f32x2v __attribute__((ext_vector_type(2)));
            f32x2v s2 = (f32x2v){p0[0], p0[1]} + (f32x2v){p1[0], p1[1]};
#pragma unroll
            for (int r = 2; r < 16; r += 2) s2 += (f32x2v){p0[r], p0[r + 1]} + (f32x2v){p1[r], p1[r + 1]};
            float ps = s2.x + s2.y;
            { auto rr = __builtin_amdgcn_permlane32_swap(__float_as_uint(ps), __float_as_uint(ps), false, false); ps = __uint_as_float(rr[0]) + __uint_as_float(rr[1]); }
            l_reg = l_reg * alpha + ps;
            PK4(p0, 0, pa0); PK4(p0, 8, pa1); PK4(p1, 0, pa2); PK4(p1, 8, pa3);
            if (__any(alpha < 1.f)) { if (hi == 0) al_l[r32] = alpha; LDS_WAIT();
#pragma unroll
                for (int d_ = 0; d_ < 4; ++d_)
#pragma unroll
                    for (int r = 0; r < 16; ++r) o[d_][r] *= al_l[crow(r, hi)]; }
            if (!stag) pv_tile(o, vb0 + vcur * SHM_V, pa0, pa1, pa2, pa3);
        }
        const int vnext = (vcur == 2) ? 0 : vcur + 1;
        if (t + 1 < NT) { VM_WAIT(); A_WRITE((t + 1) & 1, vnext); }
        vprev = vcur; vcur = vnext;
        __syncthreads();
    }
#undef PK4
#undef A_LOAD
#undef A_WRITE
    if (hi == 0) li_l[r32] = l_reg; LDS_WAIT();
    bf16* Yw = Y + (size_t)qlo * yld + ycol0 + h * HV;
#pragma unroll
    for (int r = 0; r < 16; ++r) { const int orow = crow(r, hi); const float il = 1.f / li_l[orow];
#pragma unroll
        for (int d0 = 0; d0 < 4; ++d0) { const float v = o[d0][r] * il; const float vn = __shfl_xor(v, 1);
            if ((r32 & 1) == 0) *(GAS unsigned*)(Yw + (size_t)orow * yld + d0 * 32 + r32) = cvtpk(v, vn); } }
    __syncthreads();
}
}
namespace at8 {
typedef int v8i __attribute__((ext_vector_type(8)));
constexpr int KROW = 208, SHM_K = 64 * KROW, VROW = 80, SHM_V = 128 * VROW;
constexpr int OFF_K = 0, OFF_V = 4 * SHM_K, OFF_WS = OFF_V + 4 * SHM_V;
constexpr float THR = 2.f, POFF = 6.f;
constexpr int SC_Q = 0x79797979, SC_K = 0x7b7b7b7b, SC_V = 0x7b7b7b7b, SC_1 = 0x7f7f7f7f;
__device__ __forceinline__ unsigned pk4(float a, float b, float c, float d) { int w = 0; w = __builtin_amdgcn_cvt_pk_fp8_f32(a, b, w, false); w = __builtin_amdgcn_cvt_pk_fp8_f32(c, d, w, true); return (unsigned)w; }
__device__ __forceinline__ f32x16 mfma8(v8i a, v8i b, f32x16 c, int sa, int sb) { return __builtin_amdgcn_mfma_scale_f32_32x32x64_f8f6f4(a, b, c, 0, 0, 0, sa, 0, sb); }
__device__ __forceinline__ v8i ld32(const LAS char* p) { const v4u lo = *(const LAS v4u*)p, hi = *(const LAS v4u*)(p + 16); return (v8i){(int)lo.x, (int)lo.y, (int)lo.z, (int)lo.w, (int)hi.x, (int)hi.y, (int)hi.z, (int)hi.w}; }
__device__ __forceinline__ v2u cvt8(v4u x, float s) { v2u o; o.x = pk4(bflo(x.x) * s, bfhi(x.x) * s, bflo(x.y) * s, bfhi(x.y) * s); o.y = pk4(bflo(x.z) * s, bfhi(x.z) * s, bflo(x.w) * s, bfhi(x.w) * s); return o; }
template <int VAR> __device__ __forceinline__ void attn_unit(int h, int qb, const bf16* __restrict__ Q, const unsigned char* __restrict__ Kg, const unsigned char* __restrict__ Vg, const float2* __restrict__ rope, bf16* __restrict__ Y, int yld, int ycol0, LAS char* lds) {
    int tid_ = threadIdx.x; asm volatile("" : "+v"(tid_));
    const int tid = tid_, wid = __builtin_amdgcn_readfirstlane(tid >> 6), lane = tid & 63, r32 = lane & 31, hi = lane >> 5;
    const int NT = 4 * (qb + 1);
    const int q0 = qb * 256, qlo = q0 + wid * 32, qm = qlo + r32 - 4 * hi;
    LAS float* wsf = (LAS float*)(lds + OFF_WS) + wid * 64; LAS float* li_l = wsf; LAS float* al_l = wsf + 32;
    const int kdst = (tid >> 3) * KROW + (tid & 7) * 24, ksrc = (tid >> 3) * QLD + (tid & 7) * 24;
    const int kg = (lane & 7) + 8 * (wid & 1), cg = (lane >> 3) + 8 * (wid >> 1), k5 = (4 * kg) & 31;
    const int vdst = (4 * cg) * VROW + 32 * ((k5 >> 2) & 1) + 16 * ((4 * kg) >> 5) + 4 * (k5 >> 3), vsrc = (4 * kg) * VLD + 4 * cg;
    const unsigned char* Kh = Kg + h * QKD; const unsigned char* Vh = Vg + h * HV;
    v2u stK[3]; unsigned stV[4];
#define K_LOAD(t) do { const size_t kb_ = (size_t)(t) * 64 * QLD; _Pragma("unroll") for (int j = 0; j < 3; ++j) stK[j] = *(const GAS v2u*)(Kh + kb_ + ksrc + 8 * j); } while (0)
#define V_LOAD(t) do { const size_t vb_ = (size_t)(t) * 64 * VLD; _Pragma("unroll") for (int i = 0; i < 4; ++i) stV[i] = *(const GAS unsigned*)(Vh + vb_ + vsrc + i * VLD); } while (0)
#define VT4(j) __builtin_amdgcn_perm(__builtin_amdgcn_perm(stV[3], stV[2], (4u + (j)) << 8 | (j)), __builtin_amdgcn_perm(stV[1], stV[0], (4u + (j)) << 8 | (j)), 0x05040100u)
#define K_WRITE(b3) do { _Pragma("unroll") for (int j = 0; j < 3; ++j) *(LAS v2u*)(lds + OFF_K + (b3) * SHM_K + kdst + 8 * j) = stK[j]; } while (0)
#define V_WRITE(bf) do { LAS char* vp_ = lds + OFF_V + (bf) * SHM_V + vdst; \
          *(LAS unsigned*)(vp_) = VT4(0u); *(LAS unsigned*)(vp_ + VROW) = VT4(1u); *(LAS unsigned*)(vp_ + 2 * VROW) = VT4(2u); *(LAS unsigned*)(vp_ + 3 * VROW) = VT4(3u); } while (0)
#define K_FRAGS(b3) do { const LAS char* kb = kbase + (b3) * SHM_K; _Pragma("unroll") for (int s = 0; s < 3; ++s) { kf[2 * s] = ld32(kb + 64 * s); kf[2 * s + 1] = ld32(kb + 32 * KROW + 64 * s); } } while (0)
    K_LOAD(0); V_LOAD(0);
    v8i qf[3];
    { const bf16* qp = Q + (size_t)(qlo + r32) * QLD + h * QKD;
#pragma unroll
      for (int s = 0; s < 2; ++s) { unsigned w[8];
#pragma unroll
          for (int j = 0; j < 4; ++j) { const v2u c = cvt8(*(const GAS v4u*)(qp + 64 * s + 32 * hi + 8 * j), 64.f); w[2 * j] = c.x; w[2 * j + 1] = c.y; }
          qf[s] = (v8i){(int)w[0], (int)w[1], (int)w[2], (int)w[3], (int)w[4], (int)w[5], (int)w[6], (int)w[7]}; }
      const float2* cs = rope + (size_t)(qlo + r32) * 32 + 16 * hi; unsigned w1[4], w2[4];
#pragma unroll
      for (int j = 0; j < 2; ++j) { const v4u a = *(const GAS v4u*)(qp + 128 + 16 * hi + 8 * j), b = *(const GAS v4u*)(qp + 160 + 16 * hi + 8 * j);
          const unsigned aw[4] = {a.x, a.y, a.z, a.w}, bw[4] = {b.x, b.y, b.z, b.w}; float y1[8], y2[8];
#pragma unroll
          for (int e = 0; e < 4; ++e) { const f32x4 c2 = *(const GAS f32x4*)(cs + 8 * j + 2 * e);
              const float l1 = bflo(aw[e]), h1 = bfhi(aw[e]), l2 = bflo(bw[e]), h2 = bfhi(bw[e]);
              y1[2 * e] = (l1 * c2.x - l2 * c2.y) * 64.f; y1[2 * e + 1] = (h1 * c2.z - h2 * c2.w) * 64.f; y2[2 * e] = (l1 * c2.y + l2 * c2.x) * 64.f; y2[2 * e + 1] = (h1 * c2.w + h2 * c2.z) * 64.f; }
          w1[2 * j] = pk4(y1[0], y1[1], y1[2], y1[3]); w1[2 * j + 1] = pk4(y1[4], y1[5], y1[6], y1[7]); w2[2 * j] = pk4(y2[0], y2[1], y2[2], y2[3]); w2[2 * j + 1] = pk4(y2[4], y2[5], y2[6], y2[7]); }
      qf[2] = (v8i){(int)w1[0], (int)w1[1], (int)w1[2], (int)w1[3], (int)w2[0], (int)w2[1], (int)w2[2], (int)w2[3]}; }
    { v2u k1_[3]; unsigned v1_[4];
#pragma unroll
      for (int j = 0; j < 3; ++j) k1_[j] = *(const GAS v2u*)(Kh + (size_t)64 * QLD + ksrc + 8 * j);
#pragma unroll
      for (int i = 0; i < 4; ++i) v1_[i] = *(const GAS unsigned*)(Vh + (size_t)64 * VLD + vsrc + i * VLD);
      VM_WAIT(); K_WRITE(0); V_WRITE(0);
#pragma unroll
      for (int j = 0; j < 3; ++j) stK[j] = k1_[j];
#pragma unroll
      for (int i = 0; i < 4; ++i) stV[i] = v1_[i];
      K_WRITE(1); V_WRITE(1); }
    __syncthreads();
    float m_reg = 0.f, l_reg = 0.f; f32x16 o[4];
    { float z_ = 0.f; asm volatile("" : "+v"(z_));
#pragma unroll
      for (int d_ = 0; d_ < 4; ++d_)
#pragma unroll
          for (int r = 0; r < 16; ++r) o[d_][r] = z_; }
    const LAS char* kbase = lds + OFF_K + r32 * KROW + 32 * hi;
    const LAS char* vbase = lds + OFF_V + r32 * VROW + 32 * hi;
    for (int t = 0; t < NT; ++t) {
        if (t + 2 < NT) { K_LOAD(t + 2); V_LOAD(t + 2); }
        f32x16 p0, p1;
        const bool live = t * 64 <= qlo + 31;
        if (live) {
        { float z_ = POFF - m_reg; asm volatile("" : "+v"(z_));
#pragma unroll
          for (int r = 0; r < 16; ++r) { p0[r] = z_; p1[r] = z_; } }
        { v8i kf[6]; K_FRAGS(t & 3);
          __builtin_amdgcn_sched_barrier(0);
#pragma unroll
          for (int s = 0; s < 3; ++s) { p0 = mfma8(kf[2 * s], qf[s], p0, SC_K, SC_Q); p1 = mfma8(kf[2 * s + 1], qf[s], p1, SC_K, SC_Q); } }
        }
        v8i vf[4];
        if (live) { const LAS char* vb = vbase + (t & 3) * SHM_V;
#pragma unroll
          for (int db = 0; db < 4; ++db) vf[db] = ld32(vb + 32 * db * VROW);
          __builtin_amdgcn_sched_barrier(0); }
        if (live) {
        { const int kb_ = t * 64; if (kb_ + 63 > qlo) { asm volatile("" ::: "memory"); at::mask_tile(p0, p1, qm - kb_); } }
        float pmax = p0[0];
#pragma unroll
        for (int r = 1; r < 16; ++r) pmax = fmaxf(pmax, p0[r]);
#pragma unroll
        for (int r = 0; r < 16; ++r) pmax = fmaxf(pmax, p1[r]);
        { auto rr = __builtin_amdgcn_permlane32_swap(__float_as_uint(pmax), __float_as_uint(pmax), false, false); pmax = fmaxf(__uint_as_float(rr[0]), __uint_as_float(rr[1])); }
        float alpha = 1.f;
        if (!__all(pmax <= THR + POFF)) {
            const float dm = fmaxf(pmax - POFF, 0.f); alpha = __builtin_amdgcn_exp2f(-dm); m_reg += dm;
#pragma unroll
            for (int r = 0; r < 16; ++r) { p0[r] -= dm; p1[r] -= dm; } }
#pragma unroll
        for (int r = 0; r < 16; ++r) { p0[r] = __builtin_amdgcn_exp2f(p0[r]); p1[r] = __builtin_amdgcn_exp2f(p1[r]); }
        typedef float f32x2v __attribute__((ext_vector_type(2)));
        f32x2v s2 = (f32x2v){p0[0], p0[1]} + (f32x2v){p1[0], p1[1]};
#pragma unroll
        for (int r = 2; r < 16; r += 2) s2 += (f32x2v){p0[r], p0[r + 1]} + (f32x2v){p1[r], p1[r + 1]};
        float ps = s2.x + s2.y;
        { auto rr = __builtin_amdgcn_permlane32_swap(__float_as_uint(ps), __float_as_uint(ps), false, false); ps = __uint_as_float(rr[0]) + __uint_as_float(rr[1]); }
        l_reg = l_reg * alpha + ps;
        const v8i pf = (v8i){(int)pk4(p0[0], p0[1], p0[2], p0[3]), (int)pk4(p0[4], p0[5], p0[6], p0[7]), (int)pk4(p0[8], p0[9], p0[10], p0[11]), (int)pk4(p0[12], p0[13], p0[14], p0[15]),
                             (int)pk4(p1[0], p1[1], p1[2], p1[3]), (int)pk4(p1[4], p1[5], p1[6], p1[7]), (int)pk4(p1[8], p1[9], p1[10], p1[11]), (int)pk4(p1[12], p1[13], p1[14], p1[15])};
        if (__any(alpha < 1.f)) { if (hi == 0) al_l[r32] = alpha; LDS_WAIT();
#pragma unroll
            for (int d_ = 0; d_ < 4; ++d_)
#pragma unroll
                for (int r = 0; r < 16; ++r) o[d_][r] *= al_l[at::crow(r, hi)]; }
        {
#pragma unroll
          for (int db = 0; db < 4; ++db) o[db] = mfma8(pf, vf[db], o[db], SC_1, SC_V); }
        }
        if (t + 2 < NT) { VM_WAIT(); K_WRITE((t + 2) & 3); V_WRITE((t + 2) & 3); }
        if (t & 1) __syncthreads();
    }
#undef K_LOAD
#undef V_LOAD
#undef K_WRITE
#undef V_WRITE
#undef K_FRAGS
#undef VT4
    if (hi == 0) li_l[r32] = l_reg; LDS_WAIT();
    bf16* Yw = Y + (size_t)qlo * yld + ycol0 + h * HV;
#pragma unroll
    for (int r = 0; r < 16; ++r) { const int orow = at::crow(r, hi); const float il = 1.f / li_l[orow];
#pragma unroll
        for (int d0 = 0; d0 < 4; ++d0) { const float v = o[d0][r] * il; const float vn = __shfl_xor(v, 1);
            if ((r32 & 1) == 0) *(GAS unsigned*)(Yw + (size_t)orow * yld + d0 * 32 + r32) = at::cvtpk(v, vn); } }
    __syncthreads();
}
}
namespace s5 {
constexpr int G = 32, P = 64, C = 16, T = 64, NCH = M / T;
struct Par { const float *a_re, *a_im, *b_re, *b_im, *c_re, *c_im, *d, *log_dt; };
__device__ __forceinline__ void lam_of(const Par& q, int g, int p, float& lr, float& li, float& dt) { lr = fminf(q.a_re[g * P + p], -1e-4f); li = q.a_im[g * P + p]; dt = expf(q.log_dt[g]); }
__device__ __forceinline__ float2 cmul(float2 a, float2 b) { return make_float2(a.x * b.x - a.y * b.y, a.x * b.y + a.y * b.x); }
__device__ __forceinline__ float2 lam_pow(float lr, float li, float dt, float k) { const float e = expf(lr * dt * k); float sn, cs; sincosf(li * dt * k, &sn, &cs); return make_float2(e * cs, e * sn); }
__device__ __forceinline__ float2 coef_of(float lr, float li, float dt) { const float2 lb = lam_pow(lr, li, dt, 1.f); const float nr = lb.x - 1.f, ni = lb.y, den = lr * lr + li * li; return make_float2((nr * lr + ni * li) / den, (ni * lr - nr * li) / den); }
__device__ __forceinline__ void gen_kc(Frame& F, const Par& q, float* __restrict__ Kc) {
    const int nth = F.NGW * 64;
    for (int i = opq_s(F.gw) * 64 + (opq((int)threadIdx.x) & 63); i < G * T * C; i += nth) {
        const int c = i & 15, lag = (i >> 4) & 63, g = i >> 10;
        float acc[16];
#pragma unroll
        for (int j = 0; j < 16; ++j) acc[j] = 0.f;
        for (int p = 0; p < P; ++p) {
            float lr, li, dt; lam_of(q, g, p, lr, li, dt);
            const float2 w = cmul(cmul(make_float2(q.c_re[(g * C + c) * P + p], q.c_im[(g * C + c) * P + p]), lam_pow(lr, li, dt, (float)lag)), coef_of(lr, li, dt));
            const float* br = q.b_re + (size_t)(g * P + p) * C; const float* bi = q.b_im + (size_t)(g * P + p) * C;
#pragma unroll
            for (int j = 0; j < 16; ++j) acc[j] += w.x * br[j] - w.y * bi[j];
        }
        if (lag == 0) acc[c] += q.d[g * C + c];
        float* o = Kc + (size_t)i * 16;
#pragma unroll
        for (int j = 0; j < 16; j += 4) *(GAS f32x4*)(o + j) = (f32x4){acc[j], acc[j + 1], acc[j + 2], acc[j + 3]};
    }
}
__device__ __forceinline__ void gen_pw(Frame& F, const Par& q, float2* __restrict__ PW) {
    const int nth = F.NGW * 64;
    for (int i = opq_s(F.gw) * 64 + (opq((int)threadIdx.x) & 63); i < G * P * 66; i += nth) {
        const int k = i % 66, gp = i / 66, p = gp & 63, g = gp >> 6; float lr, li, dt; lam_of(q, g, p, lr, li, dt);
        PW[i] = (k == 65) ? coef_of(lr, li, dt) : lam_pow(lr, li, dt, (float)k);
    }
}
__device__ __forceinline__ void gen_mats(Frame& F, const Par& q, const float* __restrict__ Kc, const float2* __restrict__ PW, bf16* __restrict__ Kmat, bf16* __restrict__ Hmat) {
    const int nth = F.NGW * 64, t0 = opq_s(F.gw) * 64 + (opq((int)threadIdx.x) & 63);
    for (int i = t0; i < G * 1024 * 144; i += nth) {
        const int kc = i % 144, n = (i / 144) & 1023, g = i / (144 * 1024), t = n >> 4, c = n & 15;
        v4u o = {0u, 0u, 0u, 0u};
        if (kc < 128) { const int s = kc >> 1, c0 = (kc & 1) * 8;
            if (t >= s) { const float* kp = Kc + ((size_t)(g * T + (t - s)) * C + c) * 16 + c0; const f32x4 a = *(const GAS f32x4*)kp, b = *(const GAS f32x4*)(kp + 4);
                o.x = pk2(a.x, a.y); o.y = pk2(a.z, a.w); o.z = pk2(b.x, b.y); o.w = pk2(b.z, b.w); } }
        else { const int p0 = (kc - 128) * 4; unsigned w[4];
#pragma unroll
            for (int j = 0; j < 4; ++j) { const int p = p0 + j;
                const float2 v = cmul(make_float2(q.c_re[(g * C + c) * P + p], q.c_im[(g * C + c) * P + p]), PW[(size_t)(g * P + p) * 66 + t + 1]); w[j] = pk2(v.x, -v.y); }
            o.x = w[0]; o.y = w[1]; o.z = w[2]; o.w = w[3]; }
        *(GAS v4u*)(Kmat + ((size_t)(g * 1024 + n) * 1152 + kc * 8)) = o;
    }
    for (int i = t0; i < G * 256 * 128; i += nth) {
        const int kc = i & 127, n = (i >> 7) & 255, g = i >> 15;
        v4u o = {0u, 0u, 0u, 0u};
        if (n < 128) { const int p = n >> 1, r = n & 1, s = kc >> 1, c0 = (kc & 1) * 8;
            const float2 w = cmul(PW[(size_t)(g * P + p) * 66 + 63 - s], PW[(size_t)(g * P + p) * 66 + 65]);
            const float* br = q.b_re + (size_t)(g * P + p) * C + c0; const float* bi = q.b_im + (size_t)(g * P + p) * C + c0; float v[8];
#pragma unroll
            for (int j = 0; j < 8; ++j) v[j] = r ? (w.x * bi[j] + w.y * br[j]) : (w.x * br[j] - w.y * bi[j]);
            o.x = pk2(v[0], v[1]); o.y = pk2(v[2], v[3]); o.z = pk2(v[4], v[5]); o.w = pk2(v[6], v[7]); }
        *(GAS v4u*)(Hmat + ((size_t)(g * 256 + n) * 1024 + kc * 8)) = o;
    }
}
struct OrderE { int G_, c;
    __device__ bool next(int i, pg8::Unit& u) const { const int L_ = i * G_ + c; if (L_ >= G) return false; u.pm = L_; u.pn = 0; u.pa = L_; u.pb = L_; return true; }
    __device__ __forceinline__ void a_ready(const pg8::Unit&) const {} __device__ __forceinline__ void done(const pg8::Unit&) const {} };
struct OrderY { int G_, c;
    __device__ bool next(int i, pg8::Unit& u) const { const int L_ = i * G_ + c; if (L_ >= G * 4) return false; u.pm = L_ >> 2; u.pn = L_ & 3; u.pa = u.pm; u.pb = L_; return true; }
    __device__ __forceinline__ void a_ready(const pg8::Unit&) const {} __device__ __forceinline__ void done(const pg8::Unit&) const {} };
struct EpiE {
    static constexpr bool PERM = false, AFTER_DRAIN = false;
    float* E;
    __device__ __forceinline__ void operator()(const pg8::f32x4 (&acc)[2][2][4][2], const pg8::Unit& u, int wr, int wc, int fr, int fq) const {
        { const int ln_ = opq((int)threadIdx.x) & 63; fr = ln_ & 15; fq = ln_ >> 4; }
#pragma unroll
        for (int ai = 0; ai < 2; ++ai)
#pragma unroll
            for (int m = 0; m < 4; ++m) { const int row = u.pm * 256 + ai * 128 + wr * 64 + m * 16 + fr;
#pragma unroll
                for (int n = 0; n < 2; ++n) *(GAS pg8::f32x4*)(E + (size_t)row * 128 + wc * 32 + n * 16 + 4 * fq) = acc[ai][0][m][n]; }
    }
};
__device__ __forceinline__ float gelu_t(float x) { const float u2 = 1.5957691216057308f * (x + 0.044715f * x * x * x); return x * __builtin_amdgcn_rcpf(1.f + __expf(-u2)); }
struct EpiY {
    static constexpr bool PERM = true, AFTER_DRAIN = false;
    bf16* YG;
    __device__ __forceinline__ void operator()(const pg8::f32x4 (&acc)[2][2][4][2], const pg8::Unit& u, int wr, int wc, int fr, int fq) const {
        { const int ln_ = opq((int)threadIdx.x) & 63; fr = ln_ & 15; fq = ln_ >> 4; }
#pragma unroll
        for (int ai = 0; ai < 2; ++ai)
#pragma unroll
            for (int m = 0; m < 4; ++m) { const int chunk = ai * 128 + wr * 64 + m * 16 + fr;
#pragma unroll
                for (int bj = 0; bj < 2; ++bj) { const int n0 = u.pn * 256 + bj * 128 + wc * 32 + 8 * fq, t = n0 >> 4, c0 = n0 & 15;
                    const pg8::f32x4 v0 = acc[ai][bj][m][0], v1 = acc[ai][bj][m][1];
                    v4u w; w.x = pg8::cvt_pk_bf16(gelu_t(v0[0]), gelu_t(v0[1])); w.y = pg8::cvt_pk_bf16(gelu_t(v0[2]), gelu_t(v0[3]));
                    w.z = pg8::cvt_pk_bf16(gelu_t(v1[0]), gelu_t(v1[1])); w.w = pg8::cvt_pk_bf16(gelu_t(v1[2]), gelu_t(v1[3]));
                    *(GAS v4u*)(YG + (size_t)(chunk * 64 + t) * 512 + u.pm * 16 + c0) = w; } }
    }
};
struct EpiGlu {
    static constexpr bool PERM = true, AFTER_DRAIN = false;
    const bf16* YG; const float* bias; bf16* Y;
    __device__ __forceinline__ void operator()(const pg8::f32x4 (&acc)[2][2][4][2], const pg8::Unit& u, int wr, int wc, int fr, int fq) const {
        { const int ln_ = opq((int)threadIdx.x) & 63; fr = ln_ & 15; fq = ln_ >> 4; }
#pragma unroll
        for (int bj = 0; bj < 2; ++bj) { const int col = u.pn * 256 + bj * 128 + wc * 32 + 8 * fq;
            const f32x4 b0 = *(const GAS f32x4*)(bias + col), b1 = *(const GAS f32x4*)(bias + col + 4);
#pragma unroll
            for (int ai = 0; ai < 2; ++ai)
#pragma unroll
                for (int m = 0; m < 4; ++m) { const int row = u.pm * 256 + ai * 128 + wr * 64 + m * 16 + fr;
                    const v4u yv = *(const GAS v4u*)(YG + (size_t)row * 512 + col);
                    const pg8::f32x4 z0 = acc[ai][bj][m][0], z1 = acc[ai][bj][m][1];
                    v4u w; w.x = pg8::cvt_pk_bf16(bflo(yv.x) * sigmoidf_(z0[0] + b0.x), bfhi(yv.x) * sigmoidf_(z0[1] + b0.y)); w.y = pg8::cvt_pk_bf16(bflo(yv.y) * sigmoidf_(z0[2] + b0.z), bfhi(yv.y) * sigmoidf_(z0[3] + b0.w));
                    w.z = pg8::cvt_pk_bf16(bflo(yv.z) * sigmoidf_(z1[0] + b1.x), bfhi(yv.z) * sigmoidf_(z1[1] + b1.y)); w.w = pg8::cvt_pk_bf16(bflo(yv.w) * sigmoidf_(z1[2] + b1.z), bfhi(yv.w) * sigmoidf_(z1[3] + b1.w));
                    *(GAS v4u*)(Y + (size_t)row * D + col) = w; asm volatile("" ::: "memory"); } }
    }
};
__device__ __forceinline__ void carry(Frame& F, int wave0, const Par& q, const float* __restrict__ E, bf16* __restrict__ U2) {
    const int lane = (opq((int)threadIdx.x) & 63);
    const int gwr = opq_s(F.gw) - wave0; if (gwr < 0 || gwr >= 4 * G) return;
    const int g = gwr >> 2, seg = gwr & 3;
    float lr, li, dt; lam_of(q, g, lane, lr, li, dt);
    const float2 a = lam_pow(lr, li, dt, 64.f), A = lam_pow(lr, li, dt, 4096.f);
    const float2* Eg = (const float2*)(E + (size_t)g * 256 * 128) + lane + (size_t)(64 * seg) * 64; unsigned* Ug = (unsigned*)(U2 + (size_t)g * 256 * 1152 + 1024) + lane + (size_t)(64 * seg) * 576;
    float sr = 0.f, si = 0.f;
    for (int c0 = 0; c0 < 64; c0 += 32) {
        float2 e[32];
#pragma unroll
        for (int j = 0; j < 32; ++j) e[j] = Eg[(size_t)(c0 + j) * 64];
#pragma unroll
        for (int j = 0; j < 32; ++j) { const float nr = a.x * sr - a.y * si + e[j].x, ni = a.x * si + a.y * sr + e[j].y; sr = nr; si = ni; }
    }
    LAS float* ex = (LAS float*)F.lds + ((opq_s(F.wave) >> 2) * 4) * 128;
    ex[(seg * 64 + lane) * 2] = sr; ex[(seg * 64 + lane) * 2 + 1] = si;
    __syncthreads();
    sr = 0.f; si = 0.f;
    for (int k = 0; k < seg; ++k) { const float er = ex[(k * 64 + lane) * 2], ei = ex[(k * 64 + lane) * 2 + 1]; const float nr = A.x * sr - A.y * si + er, ni = A.x * si + A.y * sr + ei; sr = nr; si = ni; }
    for (int c0 = 0; c0 < 64; c0 += 32) {
        float2 e[32];
#pragma unroll
        for (int j = 0; j < 32; ++j) e[j] = Eg[(size_t)(c0 + j) * 64];
#pragma unroll
        for (int j = 0; j < 32; ++j) { Ug[(size_t)(c0 + j) * 576] = pk2(sr, si); const float nr = a.x * sr - a.y * si + e[j].x, ni = a.x * si + a.y * sr + e[j].y; sr = nr; si = ni; }
    }
    __syncthreads();
}
}
namespace hg {
constexpr int B_OFF = 0, BSTR = 129;
constexpr int QT_OFF = 33024, QI_OFF = 50432, KI_OFF = 67840, VT_OFF = 111360;
constexpr int KT_OFF = 33024, VSA_OFF = 51456;
constexpr int RS_OFF = 129792;
constexpr int R128 = 272, R64 = 144;
__device__ __forceinline__ pg8::f32x4 mfma16(bf16x8 a, bf16x8 b, pg8::f32x4 c) { return __builtin_amdgcn_mfma_f32_16x16x32_bf16(a, b, c, 0, 0, 0); }
__device__ __forceinline__ void cum_logf_r(const v4u z0, const v4u z1, const float* __restrict__ lb, int h, LAS unsigned char* lds, int tid) {
    LAS float* B = (LAS float*)(lds + B_OFF);
    const int t = tid >> 3, d0 = (tid & 7) * 16;
    { const unsigned zw[8] = {z0.x, z0.y, z0.z, z0.w, z1.x, z1.y, z1.z, z1.w};
#pragma unroll
      for (int j = 0; j < 8; ++j) { const float l0 = lb[h * 128 + d0 + 2 * j], l1 = lb[h * 128 + d0 + 2 * j + 1];
          B[t * BSTR + d0 + 2 * j] = __logf(l0 + (1.f - l0) * sigmoidf_(bflo(zw[j]))); B[t * BSTR + d0 + 2 * j + 1] = __logf(l1 + (1.f - l1) * sigmoidf_(bfhi(zw[j]))); } }
    __syncthreads();
    const int d = tid & 127, qtr = tid >> 7;
    { float run = 0.f;
#pragma unroll
      for (int i = 0; i < 16; ++i) { run += B[(16 * qtr + i) * BSTR + d]; B[(16 * qtr + i) * BSTR + d] = run; } }
    __syncthreads();
    float offs = 0.f;
    for (int q2 = 0; q2 < qtr; ++q2) offs += B[(16 * q2 + 15) * BSTR + d];
    __syncthreads();
#pragma unroll
    for (int i = 0; i < 16; ++i) B[(16 * qtr + i) * BSTR + d] += offs;
    __syncthreads();
}
__device__ __forceinline__ void cum_logf(const bf16* __restrict__ P, const float* __restrict__ lb, int t0, int h, LAS unsigned char* lds, int tid) {
    const int t = tid >> 3, d0 = (tid & 7) * 16; const bf16* zp = P + (size_t)(t0 + t) * NPROJ + P_HF + h * 128 + d0;
    const v4u z0 = *(const GAS v4u*)zp, z1 = *(const GAS v4u*)(zp + 8); cum_logf_r(z0, z1, lb, h, lds, tid);
}
__device__ __forceinline__ void stage_vt_r(const v4u v0, const v4u v1, LAS unsigned char* lds, int vs_off, int tid);
__device__ __forceinline__ void stage_vt(const bf16* __restrict__ P, int t0, int h, LAS unsigned char* lds, int vs_off, int tid) {
    const int t = tid >> 3, e0 = (tid & 7) * 16; const bf16* vp = P + (size_t)(t0 + t) * NPROJ + P_HI + h * 128 + e0;
    const v4u v0 = *(const GAS v4u*)vp, v1 = *(const GAS v4u*)(vp + 8); stage_vt_r(v0, v1, lds, vs_off, tid);
}
__device__ __forceinline__ void stage_vt_r(const v4u v0, const v4u v1, LAS unsigned char* lds, int vs_off, int tid) {
    { const int t = tid >> 3, e0 = (tid & 7) * 16;
      *(LAS v4u*)(lds + vs_off + t * R128 + e0 * 2) = v0; *(LAS v4u*)(lds + vs_off + t * R128 + e0 * 2 + 16) = v1; }
    __syncthreads();
#pragma unroll
    for (int it = 0; it < 2; ++it) { const int id = tid + 512 * it, e = id & 127, s0 = (id >> 7) * 8;
        unsigned short v[8];
#pragma unroll
        for (int j = 0; j < 8; ++j) v[j] = *(const LAS unsigned short*)(lds + vs_off + (s0 + j) * R128 + e * 2);
        v4u o; o.x = v[0] | ((unsigned)v[1] << 16); o.y = v[2] | ((unsigned)v[3] << 16); o.z = v[4] | ((unsigned)v[5] << 16); o.w = v[6] | ((unsigned)v[7] << 16);
        *(LAS v4u*)(lds + VT_OFF + e * R64 + s0 * 2) = o; }
    __syncthreads();
}
__device__ __forceinline__ void unit_a(int unit, const bf16* __restrict__ P, const float* __restrict__ lb, float* __restrict__ UT, float* __restrict__ Gv, LAS unsigned char* lds) {
    const int tid = opq((int)threadIdx.x), wid = __builtin_amdgcn_readfirstlane(tid >> 6), lane = tid & 63, r = lane & 15, q = lane >> 4;
    const int c = unit >> 2, h = unit & 3, t0 = c * 64;
    cum_logf(P, lb, t0, h, lds, tid);
    LAS float* B = (LAS float*)(lds + B_OFF);
    { const int t = tid >> 3, d0 = (tid & 7) * 16; const bf16* zp = P + (size_t)(t0 + t) * NPROJ + P_HF + h * 128 + d0; const v4u z0 = *(const GAS v4u*)zp, z1 = *(const GAS v4u*)(zp + 8);
      const unsigned zw[8] = {z0.x, z0.y, z0.z, z0.w, z1.x, z1.y, z1.z, z1.w};
#pragma unroll
      for (int j = 0; j < 16; ++j) { const int d = d0 + j; const float z = (j & 1) ? bfhi(zw[j >> 1]) : bflo(zw[j >> 1]); const float l = lb[h * 128 + d];
          const float kt = (1.f - l) * sigmoidf_(-z) * __expf(B[63 * BSTR + d] - B[t * BSTR + d]);
          *(LAS unsigned short*)(lds + KT_OFF + d * R64 + t * 2) = (unsigned short)f2bf(kt); } }
    if (tid < 128) Gv[(size_t)unit * 128 + tid] = __expf(B[63 * BSTR + tid]);
    stage_vt(P, t0, h, lds, VSA_OFF, tid);
    bf16x8 a[2];
#pragma unroll
    for (int ks = 0; ks < 2; ++ks) a[ks] = *(const LAS bf16x8*)(lds + VT_OFF + (16 * wid + r) * R64 + (32 * ks + 8 * q) * 2);
    float* Uo = UT + (size_t)unit * 16384;
#pragma unroll
    for (int nt = 0; nt < 8; ++nt) { pg8::f32x4 c4 = {0.f, 0.f, 0.f, 0.f};
#pragma unroll
        for (int ks = 0; ks < 2; ++ks) { const bf16x8 b = *(const LAS bf16x8*)(lds + KT_OFF + (16 * nt + r) * R64 + (32 * ks + 8 * q) * 2); c4 = mfma16(a[ks], b, c4); }
#pragma unroll
        for (int j = 0; j < 4; ++j) Uo[(16 * wid + 4 * q + j) * 128 + 16 * nt + r] = c4[j]; }
    __syncthreads();
}
__device__ __forceinline__ void scan_b(Frame& F, int wave0, const float* __restrict__ UT, const float* __restrict__ Gv, bf16* __restrict__ ST) {
    const int gwr = opq_s(F.gw) - wave0;
    if (gwr < 0 || gwr >= 512) return;
    { const int i = gwr * 64 + (opq((int)threadIdx.x) & 63);
        const int dp = i & 63, e = (i >> 6) & 127, h = i >> 13;
        float s0 = 0.f, s1 = 0.f;
        const float2* up = (const float2*)UT + ((size_t)h * 16384 + e * 128) / 2 + dp; const float2* gp = (const float2*)Gv + (size_t)h * 64 + dp;
        unsigned* sp = (unsigned*)ST + ((size_t)h * 16384 + e * 128) / 2 + dp;
        for (int c0 = 0; c0 < 256; c0 += 32) {
            float2 u[32], g[32];
#pragma unroll
            for (int j = 0; j < 32; ++j) { u[j] = up[(size_t)(c0 + j) * 32768]; g[j] = gp[(size_t)(c0 + j) * 256]; }
#pragma unroll
            for (int j = 0; j < 32; ++j) { sp[(size_t)(c0 + j) * 32768] = pk2(s0, s1); s0 = g[j].x * s0 + u[j].x; s1 = g[j].y * s1 + u[j].y; }
        }
    }
}
__device__ __forceinline__ void unit_c(int unit, const bf16* __restrict__ P, const float* __restrict__ lb, const bf16* __restrict__ ST, const float* __restrict__ onorm, bf16* __restrict__ Y, LAS unsigned char* lds) {
    const int tid = opq((int)threadIdx.x), wid = __builtin_amdgcn_readfirstlane(tid >> 6), lane = tid & 63, r = lane & 15, q = lane >> 4;
    const int c = unit >> 2, h = unit & 3, t0 = c * 64;
    v4u z0, z1, q0, q1, vv0, vv1;
    { const int t = tid >> 3, d0 = (tid & 7) * 16; const bf16* rp = P + (size_t)(t0 + t) * NPROJ + h * 128 + d0;
      z0 = *(const GAS v4u*)(rp + P_HF); z1 = *(const GAS v4u*)(rp + P_HF + 8); q0 = *(const GAS v4u*)(rp + P_HQ); q1 = *(const GAS v4u*)(rp + P_HQ + 8); vv0 = *(const GAS v4u*)(rp + P_HI); vv1 = *(const GAS v4u*)(rp + P_HI + 8); }
    bf16x8 sfr[4][4]; unsigned short gt[4][4];
    { const int mt_ = wid & 3, nh_ = wid >> 2; const bf16* Sg_ = ST + (size_t)unit * 16384;
#pragma unroll
      for (int ks = 0; ks < 4; ++ks)
#pragma unroll
          for (int n = 0; n < 4; ++n) sfr[ks][n] = *(const GAS bf16x8*)(Sg_ + (size_t)(16 * (4 * nh_ + n) + r) * 128 + 32 * ks + 8 * q);
#pragma unroll
      for (int j = 0; j < 4; ++j) { const bf16* gp_ = P + (size_t)(t0 + 16 * mt_ + 4 * q + j) * NPROJ + P_HG + h * 128;
#pragma unroll
          for (int n = 0; n < 4; ++n) gt[j][n] = gp_[16 * (4 * nh_ + n) + r]; } }
    cum_logf_r(z0, z1, lb, h, lds, tid);
    stage_vt_r(vv0, vv1, lds, KI_OFF, tid);
    LAS float* B = (LAS float*)(lds + B_OFF);
    { const int t = tid >> 3, d0 = (tid & 7) * 16, ti = t >> 4;
      const unsigned zw[8] = {z0.x, z0.y, z0.z, z0.w, z1.x, z1.y, z1.z, z1.w}, qw[8] = {q0.x, q0.y, q0.z, q0.w, q1.x, q1.y, q1.z, q1.w};
      float qv[16], kv[16], bt[16];
#pragma unroll
      for (int j = 0; j < 16; ++j) { const float z = (j & 1) ? bfhi(zw[j >> 1]) : bflo(zw[j >> 1]), qq = (j & 1) ? bfhi(qw[j >> 1]) : bflo(qw[j >> 1]); const float l = lb[h * 128 + d0 + j];
          qv[j] = siluf_(qq); kv[j] = (1.f - l) * sigmoidf_(-z); bt[j] = B[t * BSTR + d0 + j]; }
      unsigned w[8];
#pragma unroll
      for (int j = 0; j < 8; ++j) w[j] = pk2(qv[2 * j] * __expf(bt[2 * j]), qv[2 * j + 1] * __expf(bt[2 * j + 1]));
      *(LAS v4u*)(lds + QT_OFF + t * R128 + d0 * 2) = (v4u){w[0], w[1], w[2], w[3]}; *(LAS v4u*)(lds + QT_OFF + t * R128 + d0 * 2 + 16) = (v4u){w[4], w[5], w[6], w[7]};
#pragma unroll
      for (int i = 0; i < 4; ++i) {
          if (i >= ti) {
              float be[16];
#pragma unroll
              for (int j = 0; j < 16; ++j) be[j] = i ? B[(16 * i - 1) * BSTR + d0 + j] : 0.f;
#pragma unroll
              for (int j = 0; j < 8; ++j) w[j] = pk2(kv[2 * j] * __expf(fminf(be[2 * j] - bt[2 * j], 80.f)), kv[2 * j + 1] * __expf(fminf(be[2 * j + 1] - bt[2 * j + 1], 80.f)));
              const int row = 8 * i * (i + 1) + t;
              *(LAS v4u*)(lds + KI_OFF + row * R128 + d0 * 2) = (v4u){w[0], w[1], w[2], w[3]}; *(LAS v4u*)(lds + KI_OFF + row * R128 + d0 * 2 + 16) = (v4u){w[4], w[5], w[6], w[7]};
              if (i == ti) {
#pragma unroll
                  for (int j = 0; j < 8; ++j) w[j] = pk2(qv[2 * j] * __expf(bt[2 * j] - be[2 * j]), qv[2 * j + 1] * __expf(bt[2 * j + 1] - be[2 * j + 1]));
                  *(LAS v4u*)(lds + QI_OFF + t * R128 + d0 * 2) = (v4u){w[0], w[1], w[2], w[3]}; *(LAS v4u*)(lds + QI_OFF + t * R128 + d0 * 2 + 16) = (v4u){w[4], w[5], w[6], w[7]}; }
          } } }
    __syncthreads();
    const int mt = wid & 3, nh = wid >> 2;
    pg8::f32x4 acc[4];
#pragma unroll
    for (int n = 0; n < 4; ++n) acc[n] = (pg8::f32x4){0.f, 0.f, 0.f, 0.f};
    const bf16* Sg = ST + (size_t)unit * 16384;
#if !(defined(HG_DBG) && HG_DBG == 1)
#pragma unroll
    for (int ks = 0; ks < 4; ++ks) { const bf16x8 a = *(const LAS bf16x8*)(lds + QT_OFF + (16 * mt + r) * R128 + (32 * ks + 8 * q) * 2);
#pragma unroll
        for (int n = 0; n < 4; ++n) acc[n] = mfma16(a, sfr[ks][n], acc[n]); }
#endif
    __syncthreads();
#pragma unroll
    for (int k2 = 0; k2 < 2; ++k2) { const int tt = wid + 8 * k2, i = tt >> 2, j = tt & 3;
        pg8::f32x4 c4 = {0.f, 0.f, 0.f, 0.f};
        if (j <= i) {
#pragma unroll
            for (int ks = 0; ks < 4; ++ks) { const bf16x8 a = *(const LAS bf16x8*)(lds + QI_OFF + (16 * i + r) * R128 + (32 * ks + 8 * q) * 2);
                const bf16x8 b = *(const LAS bf16x8*)(lds + KI_OFF + (8 * i * (i + 1) + 16 * j + r) * R128 + (32 * ks + 8 * q) * 2); c4 = mfma16(a, b, c4); } }
#pragma unroll
        for (int jj = 0; jj < 4; ++jj) { const int t = 16 * i + 4 * q + jj, s = 16 * j + r; const float v = (j <= i && s <= t) ? c4[jj] : 0.f;
            *(LAS unsigned short*)(lds + QT_OFF + t * R64 + s * 2) = (unsigned short)f2bf(v); } }
    __syncthreads();
#pragma unroll
    for (int ks = 0; ks < 2; ++ks) { const bf16x8 a = *(const LAS bf16x8*)(lds + QT_OFF + (16 * mt + r) * R64 + (32 * ks + 8 * q) * 2);
#pragma unroll
        for (int n = 0; n < 4; ++n) { const bf16x8 b = *(const LAS bf16x8*)(lds + VT_OFF + (16 * (4 * nh + n) + r) * R64 + (32 * ks + 8 * q) * 2); acc[n] = mfma16(a, b, acc[n]); } }
    LAS float* RS = (LAS float*)(lds + RS_OFF);
    float ss[4];
#pragma unroll
    for (int j = 0; j < 4; ++j) { float s = 0.f;
#pragma unroll
        for (int n = 0; n < 4; ++n) s += acc[n][j] * acc[n][j];
        s += __shfl_xor(s, 1); s += __shfl_xor(s, 2); s += __shfl_xor(s, 4); s += __shfl_xor(s, 8); ss[j] = s; }
    if (r == 0) {
#pragma unroll
        for (int j = 0; j < 4; ++j) RS[(16 * mt + 4 * q + j) * 2 + nh] = ss[j]; }
    __syncthreads();
#pragma unroll
    for (int j = 0; j < 4; ++j) { const int t = 16 * mt + 4 * q + j; const float rstd = rsqrtf((RS[t * 2] + RS[t * 2 + 1]) * (1.f / 128.f) + RMS_EPS);
        const bf16* gp = P + (size_t)(t0 + t) * NPROJ + P_HG + h * 128; bf16* yp = Y + (size_t)(t0 + t) * D + 1536 + h * 128;
#pragma unroll
        for (int n = 0; n < 4; ++n) { const int e = 16 * (4 * nh + n) + r; yp[e] = (unsigned short)f2bf(acc[n][j] * rstd * onorm[e] * siluf_(bf2f(gt[j][n]))); } }
    __syncthreads();
}
}
constexpr int TAIL_RT0 = 128, TAIL_ROWS = 2048, TAIL_KS = 4;
struct EpiRes {
    static constexpr bool PERM = true, AFTER_DRAIN = false;
    const void* xres; bf16* O; int xf32;
    __device__ __forceinline__ void operator()(const pg8::f32x4 (&acc)[2][2][4][2], const pg8::Unit& u, int wr, int wc, int fr, int fq) const {
        { const int ln_ = opq((int)threadIdx.x) & 63; fr = ln_ & 15; fq = ln_ >> 4; }
#pragma unroll
        for (int ai = 0; ai < 2; ++ai) {
            const size_t off0 = (size_t)(u.pm * 256 + ai * 128 + wr * 64 + fr) * D + u.pn * 256 + wc * 32 + 8 * fq;
            if (xf32) {
#pragma unroll
                for (int mh = 0; mh < 2; ++mh) { f32x4 x0[2][2], x1[2][2];
#pragma unroll
                    for (int m2 = 0; m2 < 2; ++m2)
#pragma unroll
                        for (int bj = 0; bj < 2; ++bj) { const float* xp = (const float*)xres + off0 + (size_t)((mh * 2 + m2) * 16) * D + bj * 128; x0[m2][bj] = *(const GAS f32x4*)xp; x1[m2][bj] = *(const GAS f32x4*)(xp + 4); }
#pragma unroll
                    for (int m2 = 0; m2 < 2; ++m2)
#pragma unroll
                        for (int bj = 0; bj < 2; ++bj) { const int m = mh * 2 + m2; const pg8::f32x4 a0 = acc[ai][bj][m][0], a1 = acc[ai][bj][m][1]; const f32x4 p = x0[m2][bj], q = x1[m2][bj];
                            v4u w; w.x = pg8::cvt_pk_bf16(ALPHA * p.x + a0[0], ALPHA * p.y + a0[1]); w.y = pg8::cvt_pk_bf16(ALPHA * p.z + a0[2], ALPHA * p.w + a0[3]);
                            w.z = pg8::cvt_pk_bf16(ALPHA * q.x + a1[0], ALPHA * q.y + a1[1]); w.w = pg8::cvt_pk_bf16(ALPHA * q.z + a1[2], ALPHA * q.w + a1[3]);
                            *(GAS v4u*)(O + off0 + (size_t)(m * 16) * D + bj * 128) = w; }
                    asm volatile("" ::: "memory"); }
            } else { v4u xb[4][2];
#pragma unroll
                for (int m = 0; m < 4; ++m)
#pragma unroll
                    for (int bj = 0; bj < 2; ++bj) xb[m][bj] = *(const GAS v4u*)((const bf16*)xres + off0 + (size_t)(m * 16) * D + bj * 128);
#pragma unroll
                for (int m = 0; m < 4; ++m)
#pragma unroll
                    for (int bj = 0; bj < 2; ++bj) { const pg8::f32x4 a0 = acc[ai][bj][m][0], a1 = acc[ai][bj][m][1]; const v4u x = xb[m][bj];
                        v4u w; w.x = pg8::cvt_pk_bf16(ALPHA * bflo(x.x) + a0[0], ALPHA * bfhi(x.x) + a0[1]); w.y = pg8::cvt_pk_bf16(ALPHA * bflo(x.y) + a0[2], ALPHA * bfhi(x.y) + a0[3]);
                        w.z = pg8::cvt_pk_bf16(ALPHA * bflo(x.z) + a1[0], ALPHA * bfhi(x.z) + a1[1]); w.w = pg8::cvt_pk_bf16(ALPHA * bflo(x.w) + a1[2], ALPHA * bfhi(x.w) + a1[3]);
                        *(GAS v4u*)(O + off0 + (size_t)(m * 16) * D + bj * 128) = w; }
                asm volatile("" ::: "memory"); }
        }
    }
};
struct EpiSwiglu {
    static constexpr bool PERM = true, AFTER_DRAIN = false;
    bf16* H; int ldh; float sc; const float* rs;
    __device__ __forceinline__ void operator()(const pg8::f32x4 (&acc)[2][2][4][2], const pg8::Unit& u, int wr, int wc, int fr, int fq) const {
        { const int ln_ = opq((int)threadIdx.x) & 63; fr = ln_ & 15; fq = ln_ >> 4; }
        float rsv[8];
#pragma unroll
        for (int k = 0; k < 8; ++k) rsv[k] = rs ? rs[u.pm * 256 + (k >> 2) * 128 + wr * 64 + (k & 3) * 16 + fr] : 1.f;
#pragma unroll
        for (int ai = 0; ai < 2; ++ai)
#pragma unroll
            for (int m = 0; m < 4; ++m) { const int row = u.pm * 256 + ai * 128 + wr * 64 + m * 16 + fr;
                const float s1 = sc * rsv[ai * 4 + m];
                const pg8::f32x4 g0 = acc[ai][0][m][0] * s1, g1 = acc[ai][0][m][1] * s1, u0 = acc[ai][1][m][0] * s1, u1 = acc[ai][1][m][1] * s1;
                v4u w; w.x = pg8::cvt_pk_bf16(siluf_(g0[0]) * u0[0], siluf_(g0[1]) * u0[1]); w.y = pg8::cvt_pk_bf16(siluf_(g0[2]) * u0[2], siluf_(g0[3]) * u0[3]);
                w.z = pg8::cvt_pk_bf16(siluf_(g1[0]) * u1[0], siluf_(g1[1]) * u1[1]); w.w = pg8::cvt_pk_bf16(siluf_(g1[2]) * u1[2], siluf_(g1[3]) * u1[3]);
                *(GAS v4u*)(H + (size_t)row * ldh + u.pn * 128 + wc * 32 + 8 * fq) = w; }
    }
};
struct EpiSwiglu8 {
    static constexpr bool PERM = true, AFTER_DRAIN = false;
    unsigned char* H; int ldh; float sc, osc; const float* rs;
    __device__ __forceinline__ void operator()(const pg8::f32x4 (&acc)[2][2][4][2], const pg8::Unit& u, int wr, int wc, int fr, int fq) const {
        { const int ln_ = opq((int)threadIdx.x) & 63; fr = ln_ & 15; fq = ln_ >> 4; }
        float rsv[8];
#pragma unroll
        for (int k = 0; k < 8; ++k) rsv[k] = rs[u.pm * 256 + (k >> 2) * 128 + wr * 64 + (k & 3) * 16 + fr];
#pragma unroll
        for (int ai = 0; ai < 2; ++ai)
#pragma unroll
            for (int m = 0; m < 4; ++m) { const int row = u.pm * 256 + ai * 128 + wr * 64 + m * 16 + fr;
                const float s1 = sc * rsv[ai * 4 + m], s2 = s1 * osc;
                const pg8::f32x4 g0 = acc[ai][0][m][0] * s1, g1 = acc[ai][0][m][1] * s1, u0 = acc[ai][1][m][0] * s2, u1 = acc[ai][1][m][1] * s2;
                float h[8];
#pragma unroll
                for (int i = 0; i < 4; ++i) { h[i] = __builtin_amdgcn_fmed3f(siluf_(g0[i]) * u0[i], -448.f, 448.f); h[4 + i] = __builtin_amdgcn_fmed3f(siluf_(g1[i]) * u1[i], -448.f, 448.f); }
                v2u w; w.x = pk4_fp8(h[0], h[1], h[2], h[3]); w.y = pk4_fp8(h[4], h[5], h[6], h[7]);
                *(GAS v2u*)(H + (size_t)row * ldh + u.pn * 128 + wc * 32 + 8 * fq) = w; }
    }
};
struct EpiStoreBf {
    static constexpr bool PERM = true, AFTER_DRAIN = false;
    bf16* O; int ldo; float sc;
    __device__ __forceinline__ void operator()(const pg8::f32x4 (&acc)[2][2][4][2], const pg8::Unit& u, int wr, int wc, int fr, int fq) const {
        { const int ln_ = opq((int)threadIdx.x) & 63; fr = ln_ & 15; fq = ln_ >> 4; }
#pragma unroll
        for (int ai = 0; ai < 2; ++ai)
#pragma unroll
            for (int m = 0; m < 4; ++m) { const int row = u.pm * 256 + ai * 128 + wr * 64 + m * 16 + fr;
#pragma unroll
                for (int bj = 0; bj < 2; ++bj) { const pg8::f32x4 v0 = acc[ai][bj][m][0] * sc, v1 = acc[ai][bj][m][1] * sc;
                    v4u w; w.x = pg8::cvt_pk_bf16(v0[0], v0[1]); w.y = pg8::cvt_pk_bf16(v0[2], v0[3]); w.z = pg8::cvt_pk_bf16(v1[0], v1[1]); w.w = pg8::cvt_pk_bf16(v1[2], v1[3]);
                    *(GAS v4u*)(O + (size_t)row * ldo + u.pn * 256 + bj * 128 + wc * 32 + 8 * fq) = w; } }
    }
};
__device__ __forceinline__ void ln_core(f32x4 (&v)[8], const f32x4 (&gg)[8], const f32x4 (&bb)[8]) {
    float s = 0.f;
#pragma unroll
    for (int j = 0; j < 8; ++j) s += (v[j].x + v[j].y) + (v[j].z + v[j].w);
    const float mean = wave_sum(s) * (1.f / D); float s2 = 0.f;
#pragma unroll
    for (int j = 0; j < 8; ++j) { v[j] = v[j] - mean; s2 += (v[j].x * v[j].x + v[j].y * v[j].y) + (v[j].z * v[j].z + v[j].w * v[j].w); }
    const float rstd = rsqrtf(wave_sum(s2) * (1.f / D) + LN_EPS);
#pragma unroll
    for (int j = 0; j < 8; ++j) v[j] = v[j] * rstd * gg[j] + bb[j];
}
template <bool ROUTE> __device__ __forceinline__ void ln_pass(Frame& F, const bf16* __restrict__ PRE, const float* __restrict__ g, const float* __restrict__ b, bf16* __restrict__ Xf, bf16* __restrict__ Xb, unsigned char* __restrict__ X8, float* __restrict__ XS,
                                                              const float* __restrict__ wr, int* __restrict__ tidx, float* __restrict__ tw) {
    const int lane = (opq((int)threadIdx.x) & 63);
    f32x4 gg_[8], bb_[8];
#pragma unroll
    for (int j = 0; j < 8; ++j) { gg_[j] = *(const GAS f32x4*)(g + (j * 64 + lane) * 4); bb_[j] = *(const GAS f32x4*)(b + (j * 64 + lane) * 4); }
    if (ROUTE) {
        LAS f32x4* wl = (LAS f32x4*)F.lds;
        for (int p = opq((int)threadIdx.x); p < 4096; p += 512) { const int ln = p & 63, j = (p >> 6) & 7, hf = (p >> 9) & 1, i = p >> 10;
            const f32x4 w = *(const GAS f32x4*)(wr + (size_t)((j * 64 + ln) * 4 + i) * 8 + hf * 4); wl[p] = w; }
        __syncthreads(); }
    v2u nv[8];
    { const int t0_ = opq_s(F.gw);
#pragma unroll
      for (int j = 0; j < 8; ++j) nv[j] = *(const GAS v2u*)(PRE + (size_t)t0_ * D + (j * 64 + lane) * 4); }
    for (int t = opq_s(F.gw); t < M; t += F.NGW) {
        f32x4 v[8];
#pragma unroll
        for (int j = 0; j < 8; ++j) v[j] = (f32x4){bflo(nv[j].x), bfhi(nv[j].x), bflo(nv[j].y), bfhi(nv[j].y)};
        { const int tn = (t + F.NGW < M) ? t + F.NGW : t;
#pragma unroll
          for (int j = 0; j < 8; ++j) nv[j] = *(const GAS v2u*)(PRE + (size_t)tn * D + (j * 64 + lane) * 4); }
        ln_core(v, gg_, bb_);
#pragma unroll
        for (int j = 0; j < 8; ++j) { { v2u w; w.x = pk2(v[j].x, v[j].y); w.y = pk2(v[j].z, v[j].w); *(GAS v2u*)(Xf + (size_t)t * D + (j * 64 + lane) * 4) = w; }
            if (Xb) { v2u w; w.x = pk2(v[j].x, v[j].y); w.y = pk2(v[j].z, v[j].w); *(GAS v2u*)(Xb + (size_t)t * D + (j * 64 + lane) * 4) = w; }
            }
        if (X8) {
            float am = 0.f;
#pragma unroll
            for (int j = 0; j < 8; ++j) am = fmaxf(am, fmaxf(fmaxf(fabsf(v[j].x), fabsf(v[j].y)), fmaxf(fabsf(v[j].z), fabsf(v[j].w))));
            am = fmaxf(wave_max(am), 1e-20f); const float q = 127.f / am; if (lane == 0) XS[t] = am * (1.f / 127.f);
#pragma unroll
            for (int j = 0; j < 8; ++j) *(GAS unsigned*)(X8 + (size_t)t * D + (j * 64 + lane) * 4) = pk4_i8(v[j].x * q, v[j].y * q, v[j].z * q, v[j].w * q); }
        if (ROUTE) {
            float lg[8];
#pragma unroll
            for (int e = 0; e < 8; ++e) lg[e] = 0.f;
#pragma unroll
            for (int j = 0; j < 8; ++j) { const float xv[4] = {v[j].x, v[j].y, v[j].z, v[j].w};
#pragma unroll
                for (int i = 0; i < 4; ++i) { const LAS f32x4* wl = (const LAS f32x4*)F.lds; const f32x4 w0 = wl[((i * 2 + 0) * 8 + j) * 64 + lane], w1 = wl[((i * 2 + 1) * 8 + j) * 64 + lane];
                    lg[0] = fmaf(xv[i], w0.x, lg[0]); lg[1] = fmaf(xv[i], w0.y, lg[1]); lg[2] = fmaf(xv[i], w0.z, lg[2]); lg[3] = fmaf(xv[i], w0.w, lg[3]);
                    lg[4] = fmaf(xv[i], w1.x, lg[4]); lg[5] = fmaf(xv[i], w1.y, lg[5]); lg[6] = fmaf(xv[i], w1.z, lg[6]); lg[7] = fmaf(xv[i], w1.w, lg[7]); }
                asm volatile("" ::: "memory"); }
#pragma unroll
            for (int e = 0; e < 8; ++e) lg[e] = wave_sum(lg[e]);
            if (lane == 0) {
                int i0 = 0; float v0 = lg[0];
#pragma unroll
                for (int e = 1; e < 8; ++e) if (lg[e] > v0) { v0 = lg[e]; i0 = e; }
                int i1 = -1; float v1 = -__builtin_inff();
#pragma unroll
                for (int e = 0; e < 8; ++e) if (e != i0 && lg[e] > v1) { v1 = lg[e]; i1 = e; }
                const float e1 = __expf(v1 - v0);
                tidx[t * 2] = i0; tidx[t * 2 + 1] = i1; tw[t * 2] = 1.f / (1.f + e1); tw[t * 2 + 1] = e1 / (1.f + e1);
            }
        }
    }
}
__device__ __forceinline__ void ln_moe_pass(Frame& F, const bf16* __restrict__ X1, const bf16* __restrict__ OS, const int* __restrict__ pos, const float* __restrict__ tw,
                                            const float* __restrict__ g, const float* __restrict__ b, float* __restrict__ out, const float* __restrict__ PT, float ptsc) {
    const int lane = (opq((int)threadIdx.x) & 63);
    f32x4 gg_[8], bb_[8];
#pragma unroll
    for (int jj = 0; jj < 8; ++jj) { gg_[jj] = *(const GAS f32x4*)(g + (jj * 64 + lane) * 4); bb_[jj] = *(const GAS f32x4*)(b + (jj * 64 + lane) * 4); }
    for (int t = opq_s(F.gw); t < M; t += F.NGW) {
        const int p0 = pos[t * 2], p1 = pos[t * 2 + 1]; const float w0 = tw[t * 2], w1 = tw[t * 2 + 1];
        f32x4 v[8];
#pragma unroll
        for (int j = 0; j < 8; ++j) { const v2u xb = *(const GAS v2u*)(X1 + (size_t)t * D + (j * 64 + lane) * 4); const f32x4 x = (f32x4){bflo(xb.x), bfhi(xb.x), bflo(xb.y), bfhi(xb.y)};
            f32x4 ea, ec;
            if (PT && p0 >= TAIL_RT0 * 256) { const float* q_ = PT + (size_t)(p0 - TAIL_RT0 * 256) * D + (j * 64 + lane) * 4;
                ea = (*(const GAS f32x4*)q_ + *(const GAS f32x4*)(q_ + (size_t)TAIL_ROWS * D) + *(const GAS f32x4*)(q_ + (size_t)2 * TAIL_ROWS * D) + *(const GAS f32x4*)(q_ + (size_t)3 * TAIL_ROWS * D)) * ptsc; }
            else { const v2u a = *(const GAS v2u*)(OS + (size_t)p0 * D + (j * 64 + lane) * 4); ea = (f32x4){bflo(a.x), bfhi(a.x), bflo(a.y), bfhi(a.y)}; }
            if (PT && p1 >= TAIL_RT0 * 256) { const float* q_ = PT + (size_t)(p1 - TAIL_RT0 * 256) * D + (j * 64 + lane) * 4;
                ec = (*(const GAS f32x4*)q_ + *(const GAS f32x4*)(q_ + (size_t)TAIL_ROWS * D) + *(const GAS f32x4*)(q_ + (size_t)2 * TAIL_ROWS * D) + *(const GAS f32x4*)(q_ + (size_t)3 * TAIL_ROWS * D)) * ptsc; }
            else { const v2u c = *(const GAS v2u*)(OS + (size_t)p1 * D + (j * 64 + lane) * 4); ec = (f32x4){bflo(c.x), bfhi(c.x), bflo(c.y), bfhi(c.y)}; }
            v[j] = ALPHA * x + w0 * ea + w1 * ec; }
        ln_core(v, gg_, bb_);
#pragma unroll
        for (int j = 0; j < 8; ++j) *(GAS f32x4*)(out + (size_t)t * D + (j * 64 + lane) * 4) = v[j];
    }
}
__device__ __forceinline__ void moe_dispatch(Frame& F, const int* __restrict__ tidx, const unsigned char* __restrict__ X8, const float* __restrict__ XS, unsigned char* __restrict__ XG, float* __restrict__ XGS, int* __restrict__ pos, int* __restrict__ cntg, LAS unsigned char* lds) {
    const int tid = opq((int)threadIdx.x), lane = tid & 63, wv = __builtin_amdgcn_readfirstlane(tid >> 6);
    LAS int* sc = (LAS int*)lds;
    for (int blk = blockIdx.x; blk < 256; blk += F.G) {
        const int s_lo = blk * 128;
        int ct[8], cp[8];
#pragma unroll
        for (int e = 0; e < 8; ++e) { ct[e] = 0; cp[e] = 0; }
        for (int ib = 0; ib < 16; ib += 4) { v4u ev[4];
#pragma unroll
          for (int it = 0; it < 4; ++it) ev[it] = *(const GAS v4u*)(tidx + ((ib + it) * 512 + tid) * 4);
#pragma unroll
          for (int it = 0; it < 4; ++it) { const int s0 = ((ib + it) * 512 + tid) * 4; const int ee[4] = {(int)ev[it].x, (int)ev[it].y, (int)ev[it].z, (int)ev[it].w};
#pragma unroll
              for (int j = 0; j < 4; ++j)
#pragma unroll
                  for (int k = 0; k < 8; ++k) { const int hit = (ee[j] == k); ct[k] += hit; cp[k] += (hit && s0 + j < s_lo); } } }
#pragma unroll
        for (int e = 0; e < 8; ++e) { for (int o = 32; o >= 1; o >>= 1) { ct[e] += __shfl_xor(ct[e], o); cp[e] += __shfl_xor(cp[e], o); } }
        if (lane == 0) {
#pragma unroll
            for (int e = 0; e < 8; ++e) { sc[wv * 16 + e] = ct[e]; sc[wv * 16 + 8 + e] = cp[e]; } }
        __syncthreads();
        if (tid < 16) { int a = 0; for (int w = 0; w < 8; ++w) a += sc[w * 16 + tid]; sc[128 + tid] = a; }
        __syncthreads();
        if (tid == 0) { int o = 0; for (int e = 0; e < 8; ++e) { sc[160 + e] = o; o += (sc[128 + e] + 255) & ~255; if (blk == 0) cntg[e] = sc[128 + e]; } }
        __syncthreads();
        if (wv < 2) { const int s = s_lo + tid; const int e = tidx[s]; int rank = 0, mycnt = 0;
#pragma unroll
            for (int k = 0; k < 8; ++k) { const unsigned long long m = __ballot(e == k); if (e == k) rank = __popcll(m & ((1ull << lane) - 1ull)); if (wv == 0 && lane == k) mycnt = __popcll(m); }
            if (wv == 0 && lane < 8) sc[320 + lane] = mycnt; }
        __syncthreads();
        if (wv < 2) { const int s = s_lo + tid; const int e = tidx[s]; int rank = 0;
#pragma unroll
            for (int k = 0; k < 8; ++k) { const unsigned long long m = __ballot(e == k); if (e == k) rank = __popcll(m & ((1ull << lane) - 1ull)); }
            const int p = sc[160 + e] + sc[128 + 8 + e] + (wv == 1 ? sc[320 + e] : 0) + rank;
            pos[s] = p; sc[192 + tid] = p; }
        __syncthreads();
        for (int i0 = wv; i0 < 128; i0 += 32) {
            v4u r0[4], r1[4]; float xs[4];
#pragma unroll
            for (int k = 0; k < 4; ++k) { const int s = s_lo + i0 + 8 * k; const v4u* src = (const v4u*)(X8 + (size_t)(s >> 1) * D) + lane * 2; r0[k] = src[0]; r1[k] = src[1]; xs[k] = XS[s >> 1]; }
#pragma unroll
            for (int k = 0; k < 4; ++k) { const int p = sc[192 + i0 + 8 * k]; v4u* dst = (v4u*)(XG + (size_t)p * D) + lane * 2; dst[0] = r0[k]; dst[1] = r1[k]; if (lane == 0) XGS[p] = xs[k]; } }
        if (blk < 8) { const int c = sc[128 + blk], r0 = sc[160 + blk] + c, r1 = sc[160 + blk] + ((c + 255) & ~255); const unsigned zz = (unsigned)opq(0); const v4u z = {zz, zz, zz, zz};
            for (int i = r0 * 128 + tid; i < r1 * 128; i += 512) ((GAS v4u*)XG)[i] = z;
            for (int i = r0 + tid; i < r1; i += 512) XGS[i] = 0.f; }
        __syncthreads();
    }
}
struct OrderMoE {
    int G_, c, nN, ntile; int tl[8];
    __device__ __forceinline__ void init(const int* cnt, int nN_, int G__, int c_) { G_ = G__; c = c_; nN = nN_; ntile = 0;
#pragma unroll
        for (int e = 0; e < 8; ++e) { tl[e] = __builtin_amdgcn_readfirstlane((cnt[e] + 255) >> 8); ntile += tl[e]; } }
    __device__ bool next(int i, pg8::Unit& u) const {
        const int nwg = ntile * nN; const long L_ = (long)i * G_ + c; if (L_ >= nwg) return false;
        int wgid = (int)L_; { const int q = nwg / 8, r = nwg % 8, xcd = wgid % 8, off = wgid / 8; wgid = (xcd < r ? xcd * (q + 1) : r * (q + 1) + (xcd - r) * q) + off; }
        const int nig = 8 * nN, gid = wgid / nig, fm = gid * 8, gsz = (ntile - fm) < 8 ? (ntile - fm) : 8;
        const int rt = fm + ((wgid % nig) % gsz), pn = (wgid % nig) / gsz;
        int e = 0, cum = 0;
#pragma unroll
        for (int k = 0; k < 8; ++k) { cum += tl[k]; e += (rt >= cum) ? 1 : 0; }
        if (e > 7) e = 7;
        u.pm = rt; u.pn = pn; u.pa = rt; u.pb = e * nN + pn; return true;
    }
    __device__ __forceinline__ void a_ready(const pg8::Unit&) const {} __device__ __forceinline__ void done(const pg8::Unit&) const {}
};
struct OrderTail {
    int c, ntile; int tl[8];
    __device__ __forceinline__ void init(const int* cnt, int c_) { c = c_; ntile = 0;
#pragma unroll
        for (int e = 0; e < 8; ++e) { tl[e] = __builtin_amdgcn_readfirstlane((cnt[e] + 255) >> 8); ntile += tl[e]; } }
    __device__ bool next(int i, pg8::Unit& u) const {
        if (i > 0) return false;
        const int tu = c >> 2, rt = TAIL_RT0 + (tu >> 3), pn = tu & 7; if (rt >= ntile) return false;
        int e = 0, cum = 0;
#pragma unroll
        for (int k = 0; k < 8; ++k) { cum += tl[k]; e += (rt >= cum) ? 1 : 0; }
        if (e > 7) e = 7;
        u.pm = tu >> 3; u.pn = pn; u.pa = rt; u.pb = e * 8 + pn; return true;
    }
    __device__ __forceinline__ void a_ready(const pg8::Unit&) const {} __device__ __forceinline__ void done(const pg8::Unit&) const {}
};
struct EpiTail {
    static constexpr bool PERM = true, AFTER_DRAIN = false;
    float* P;
    __device__ __forceinline__ void operator()(const pg8::f32x4 (&acc)[2][2][4][2], const pg8::Unit& u, int wr, int wc, int fr, int fq) const {
        { const int ln_ = opq((int)threadIdx.x) & 63; fr = ln_ & 15; fq = ln_ >> 4; }
#pragma unroll
        for (int ai = 0; ai < 2; ++ai)
#pragma unroll
            for (int m = 0; m < 4; ++m) { const int row = u.pm * 256 + ai * 128 + wr * 64 + m * 16 + fr;
#pragma unroll
                for (int bj = 0; bj < 2; ++bj) { float* o = P + (size_t)row * D + u.pn * 256 + bj * 128 + wc * 32 + 8 * fq;
                    *(GAS f32x4*)o = (f32x4){acc[ai][bj][m][0][0], acc[ai][bj][m][0][1], acc[ai][bj][m][0][2], acc[ai][bj][m][0][3]};
                    *(GAS f32x4*)(o + 4) = (f32x4){acc[ai][bj][m][1][0], acc[ai][bj][m][1][1], acc[ai][bj][m][1][2], acc[ai][bj][m][1][3]}; }
                asm volatile("" ::: "memory"); }
    }
};
#ifndef REP_PHASE
#define REP_PHASE -1
#endif
#define REPB(k) for (int rep_ = 0, nrep_ = ((REP_PHASE == (k)) ? opq_s(2) : 1); rep_ < nrep_; ++rep_)
struct Args { const float* in[30]; float* out; unsigned char* ws; int ph_lo, ph_hi, li, prep_mask; };
constexpr int NPH_L = 11;
__device__ __forceinline__ unsigned char* wsl(unsigned char* p) { asm volatile("" : "+s"(p)); return p; }
__device__ __forceinline__ const float* ain(const Args& a, int i) { return a.in[opq_s(i)]; }

#ifndef MOE_Q0
#define MOE_Q0 12
#endif
#ifndef MOE_Q1
#define MOE_Q1 8
#endif
#ifndef MOE_Q2
#define MOE_Q2 12
#endif
constexpr int MOE_IT_M = (D / 64) * (DFE / 32);
constexpr int MOE_NITEMS = NE * 3 * MOE_IT_M;
constexpr int MOE_QL = MOE_Q0 + MOE_Q1 + MOE_Q2;
constexpr int MOE_DEFER = 2 * MOE_QL * 128 * NWAVES;
static_assert(MOE_DEFER <= MOE_NITEMS, "deferred quota exceeds the item count");
__device__ __forceinline__ void moe_item_load(f32x4 (&ld)[8], const Args& a, int id, int lane) {
    const int e = id / (3 * MOE_IT_M), r = id % (3 * MOE_IT_M), mtx = r / MOE_IT_M, it = r % MOE_IT_M;
    if (mtx == 2) tr_load(ld, ain(a, 29) + (size_t)e * DFE * D, D, D, it, lane);
    else tr_load(ld, ain(a, 27 + mtx) + (size_t)e * D * DFE, DFE, DFE, it, lane);
}
__device__ __forceinline__ void moe_item_store(const f32x4 (&ld)[8], Frame& F, int id, int lane) {
    unsigned char* ws = F.ws; LAS float* scr = (LAS float*)(F.lds + F.wave * 16384);
    const int e = id / (3 * MOE_IT_M), r = id % (3 * MOE_IT_M), mtx = r / MOE_IT_M, it = r % MOE_IT_M;
    if (mtx == 0) tr_store8<2, true>(ld, D, DFE, wsl(ws) + WS_MOEGU + e * (MOEGU_E / 2), WI8_Q, scr, it, lane);
    else if (mtx == 1) tr_store8<3, true>(ld, D, DFE, wsl(ws) + WS_MOEGU + e * (MOEGU_E / 2), WI8_Q, scr, it, lane);
    else tr_store8<0, false>(ld, DFE, D, wsl(ws) + WS_MOED + e * (MOED_E / 2), WD8_SCALE, scr, it, lane);
}
__device__ __forceinline__ void moe_cvt_range(Frame& F, const Args& a, int first, int last, int step, int lane) {
    if (first >= last) return;
    f32x4 ld[8], nx[8]; moe_item_load(ld, a, first, lane);
    for (int id = first; id < last; id += step) {
        const int idn = (id + step < last) ? id + step : id; moe_item_load(nx, a, idn, lane);
        moe_item_store(ld, F, id, lane);
#pragma unroll
        for (int i = 0; i < 8; ++i) ld[i] = nx[i]; }
}
__device__ __forceinline__ void moe_cvt_window(Frame& F, const Args& a, int l, int w) {
    if (F.G != 256 || (int)blockIdx.x < 128) return;
    const int q = (w == 0) ? MOE_Q0 : (w == 1) ? MOE_Q1 : MOE_Q2, woff = (w == 0) ? 0 : (w == 1) ? MOE_Q0 : MOE_Q0 + MOE_Q1;
    const int sw = ((int)blockIdx.x - 128) * NWAVES + F.wave, lane = opq((int)threadIdx.x) & 63;
    const int base = (l * MOE_QL + woff) * 1024 + sw * q;
    moe_cvt_range(F, a, base, base + q, 1, lane);
    __syncthreads();
}
__device__ __forceinline__ s5::Par s5par(const Args& a, int l) {
    return s5::Par{ain(a, 3) + l * 2048, ain(a, 4) + l * 2048, ain(a, 5) + (size_t)l * 32768, ain(a, 6) + (size_t)l * 32768, ain(a, 7) + (size_t)l * 32768, ain(a, 8) + (size_t)l * 32768, ain(a, 9) + l * 512, ain(a, 10) + l * 32};
}
__device__ __forceinline__ void prologue2(Frame& F, const Args& a) {
    if (a.prep_mask & 8) for (int l = 0; l < 2; ++l) { const s5::Par q = s5par(a, l);
        s5::gen_mats(F, q, (const float*)(wsl(F.ws) + WS_SMALL + SM_S5KC) + (size_t)l * 32 * 64 * 256, (const float2*)(wsl(F.ws) + WS_S5PW) + (size_t)l * 32 * 64 * 66, (bf16*)(wsl(F.ws) + WS_S5K + l * S5K_L), (bf16*)(wsl(F.ws) + WS_S5H + l * S5H_L)); }
}
__device__ __forceinline__ void prologue(Frame& F, const Args& a) {
    const int pm = a.prep_mask;
    unsigned char* ws = F.ws;
    if (pm & 1) {
        float2* rope = (float2*)(wsl(ws) + WS_ROPE);
        for (int i = F.gw * 64 + (opq((int)threadIdx.x) & 63); i < M * 32; i += F.NGW * 64) { const int t = i >> 5, j = i & 31; const float inv = powf(10000.f, -(float)(2 * j) / 64.f); const float ang = (float)t * inv; rope[i] = make_float2(cosf(ang), sinf(ang)); }
        quant_rows_job(F, ain(a, 0), wsl(ws) + WS_X8, (float*)(wsl(ws) + WS_SMALL + SM_XS), M);
    }
    if (pm & 16) {
        float* lbv = (float*)(wsl(ws) + WS_SMALL + SM_LB);
        for (int i = F.gw * 64 + (opq((int)threadIdx.x) & 63); i < 512; i += F.NGW * 64) { const float l0 = ain(a, 17)[i], l1 = ain(a, 17)[512 + i]; const float m = fmaxf(l0, l1), e0 = expf(l0 - m), e1 = expf(l1 - m);
            const float p0 = e0 / (e0 + e1), p1 = e1 / (e0 + e1); lbv[i] = 0.f; lbv[512 + i] = (p0 + p1) - p0; }
    }
    if (pm & 64) {
        transpose_job8<2, true>(F, ain(a, 23), D, DFF, DFF, wsl(ws) + WS_FFNGU, WI8_Q);
        transpose_job8<3, true>(F, ain(a, 24), D, DFF, DFF, wsl(ws) + WS_FFNGU, WI8_Q);
        transpose_job<0>(F, ain(a, 25), DFF, D, D, (bf16*)(wsl(ws) + WS_FFND), 0, nullptr, 1.f);
    }
    if (pm & 128) { const int lane = opq((int)threadIdx.x) & 63; const int first = (F.G == 256) ? MOE_DEFER : 0;
        moe_cvt_range(F, a, first + opq_s(F.gw), MOE_NITEMS, F.NGW, lane); }
    for (int l = 0; l < 2; ++l) {
        if (pm & 2) {
            transpose_job8<0, true>(F, ain(a, 1) + (size_t)l * D * INC, D, INC, INC, wsl(ws) + WS_WIN + l * WIN_L, WI8_Q);
            zero_job(F, wsl(ws) + WS_WIN + l * WIN_L + (size_t)INC * D, (size_t)(NPROJ - INC) * D);
        }
        if (pm & 4) {
            transpose_job<0>(F, ain(a, 14) + (size_t)l * QR * QLD, QR, QLD, QLD, (bf16*)(wsl(ws) + WS_WUQ + l * WUQ_L), 0, ain(a, 13) + l * QR, QSCALE);
            transpose_job<0>(F, ain(a, 16) + (size_t)l * KVR * 2048, KVR, 2048, 2048, (bf16*)(wsl(ws) + WS_WUKV + l * WUKV_L), 0, ain(a, 15) + l * KVR, 1.f);
        }
        if (pm & 32) transpose_job<0>(F, ain(a, 2) + (size_t)l * D * D, D, D, D, (bf16*)(wsl(ws) + WS_WOUT + l * WOUT_L), 0, nullptr, 1.f);
        if (pm & 8) {
            const s5::Par q = s5par(a, l);
            s5::gen_kc(F, q, (float*)(wsl(ws) + WS_SMALL + SM_S5KC) + (size_t)l * 32 * 64 * 256);
            s5::gen_pw(F, q, (float2*)(wsl(ws) + WS_S5PW) + (size_t)l * 32 * 64 * 66);
            transpose_job<0>(F, ain(a, 11) + (size_t)l * 512 * 512, 512, 512, 512, (bf16*)(wsl(ws) + WS_WGLU + l * WGLU_L), 0, nullptr, 1.f);
        }
    }
}

#define XB ((bf16*)(wsl(ws) + WS_XB))
#define PROJ ((bf16*)(wsl(ws) + WS_PROJ))
#define U2 ((bf16*)(wsl(ws) + WS_U2))
#define Qb ((bf16*)(wsl(ws) + WS_Q))
#define Kb ((unsigned char*)(wsl(ws) + WS_K))
#define Vb ((unsigned char*)(wsl(ws) + WS_V))
#define YCAT ((bf16*)(wsl(ws) + WS_YCAT))
#define YG ((bf16*)(wsl(ws) + WS_YG))
#define Ebuf ((float*)(wsl(ws) + WS_E))
#define HGU ((float*)(wsl(ws) + WS_HGU))
#define HGS ((bf16*)(wsl(ws) + WS_HGS))
#define HGG ((float*)(wsl(ws) + WS_HGG))
#define lbl ((const float*)(wsl(ws) + WS_SMALL + SM_LB) + l * 512)
#define rstdq ((float*)(wsl(ws) + WS_SMALL + SM_RSTDQ))
#define rstdkv ((float*)(wsl(ws) + WS_SMALL + SM_RSTDKV))
#define rope ((const float2*)(wsl(ws) + WS_ROPE))
#define PRE ((bf16*)(wsl(ws) + WS_PRE))
#define R0 ((bf16*)(wsl(ws) + WS_R0))
#define R1 ((bf16*)(wsl(ws) + WS_R1))
#define TIDX ((int*)(wsl(ws) + WS_SMALL + SM_TIDX))
#define TW ((float*)(wsl(ws) + WS_SMALL + SM_TW))
#define POS ((int*)(wsl(ws) + WS_SMALL + SM_POS))
#define CNT ((int*)(wsl(ws) + WS_SMALL + SM_CNT))
__global__ void __launch_bounds__(NWAVES * 64, 2) mk_fwd(Args args) {
    extern __shared__ __attribute__((aligned(16))) unsigned char lds[];
    Frame F;
    F.lds = (LAS unsigned char*)lds;
    F.MISC = (volatile LAS unsigned*)(F.lds + MISC_OFF);
    F.wave = __builtin_amdgcn_readfirstlane((int)threadIdx.x >> 6);
    F.G = gridDim.x; F.gw = blockIdx.x * NWAVES + F.wave; F.NGW = F.G * NWAVES;
    F.ws = args.ws; F.ctl = (gu32*)(args.ws + WS_CTL);
    unsigned char* ws = args.ws;
    for (int u = threadIdx.x; u < (LDS_BYTES - LDSCTL_OFF) / 4; u += NWAVES * 64) ((LAS unsigned*)(F.lds + LDSCTL_OFF))[u] = 0u;
    __syncthreads();
    XcdBarrier bar = xcd_barrier_post((unsigned*)(F.ctl + CW_BAR) + args.li * XCD_BAR_WORDS, F.MISC + 8);
    const int lo = args.ph_lo, hi = args.ph_hi;
#define IN(k) (lo <= (k) && (k) < hi)
#define SEAM(k) do { if (IN(k) && IN((k) + 1)) xcd_barrier(bar); } while (0)
    if (IN(0)) { REPB(100) prologue(F, args); } SEAM(0);
    if (IN(1)) { REPB(101) prologue2(F, args); } SEAM(1);
    for (int l = 0; l < 2; ++l) {
        const int pb = 2 + l * NPH_L;


        if (IN(pb + 0)) REPB(0) {
#ifndef NO_G0
            pg8::Gemm g{(const bf16*)(wsl(ws) + WS_X8), (const bf16*)(wsl(ws) + WS_WIN + l * WIN_L), M, NPROJ, D / 2, D / 2}; pg8::StaticOrder S; S.init(M, NPROJ, F.G, (int)blockIdx.x);
            EpiProj E{PROJ, U2, WI8_S, (const float*)(wsl(ws) + WS_SMALL + SM_XS)};
            pg8::gemm_phase_i8<EpiProj, pg8::StaticOrder, true, true>(F.lds, g, S, E);
#endif
            moe_cvt_window(F, args, l, 0);
        }
        SEAM(pb + 0);
        if (IN(pb + 1)) REPB(1) { thin_mla(F, PROJ, rstdq, rstdkv, Kb, rope);
#ifndef NO_S5
            { pg8::Gemm g{U2, (const bf16*)(wsl(ws) + WS_S5H + l * S5H_L), 32 * 256, 256, 1024, 1152}; s5::OrderE S{F.G, (int)blockIdx.x}; s5::EpiE E{Ebuf};
              pg8::gemm_phase<s5::EpiE, s5::OrderE, true, true>(F.lds, g, S, E); }
#endif
#ifndef NO_HG
            if (F.G == 256) { if ((int)blockIdx.x >= 32) for (int u = (int)blockIdx.x - 32; u < 1024; u += 224) hg::unit_a(u, PROJ, lbl, HGU, HGG, F.lds); }
            else for (int u = blockIdx.x; u < 1024; u += F.G) hg::unit_a(u, PROJ, lbl, HGU, HGG, F.lds);
#endif
        }
        SEAM(pb + 1);
        if (IN(pb + 2)) REPB(2) {
#ifndef NO_S5
            s5::carry(F, (F.G >= 256 ? 192 : 0) * NWAVES, s5par(args, l), Ebuf, U2);
#endif
#ifndef NO_HG
            hg::scan_b(F, (F.G >= 256 ? 128 : 0) * NWAVES, HGU, HGG, HGS);
#endif
#ifndef NO_G2
            { pg8::Gemm g{PROJ + P_CQ, (const bf16*)(wsl(ws) + WS_WUQ + l * WUQ_L), M, QLD, QR, NPROJ}; pg8::StaticOrder S; S.init(M, QLD, F.G, (int)blockIdx.x);
              EpiRS<false> E{Qb, nullptr, nullptr, rstdq};
              pg8::gemm_phase<EpiRS<false>, pg8::StaticOrder, true, true>(F.lds, g, S, E); }
            { pg8::Gemm g{PROJ + P_CKV, (const bf16*)(wsl(ws) + WS_WUKV + l * WUKV_L), M, 2048, KVR, NPROJ}; pg8::StaticOrder S; S.init(M, 2048, F.G, (int)blockIdx.x);
              EpiRS<true> E{nullptr, Kb, Vb, rstdkv};
              pg8::gemm_phase<EpiRS<true>, pg8::StaticOrder, true, true>(F.lds, g, S, E); }
#endif
        }
        SEAM(pb + 2);
        if (IN(pb + 3)) REPB(3) {
#ifndef NO_S5
            REPB(33) { pg8::Gemm g{U2, (const bf16*)(wsl(ws) + WS_S5K + l * S5K_L), 32 * 256, 1024, 1152, 1152}; s5::OrderY S{F.G, (int)blockIdx.x}; s5::EpiY E{YG};
              pg8::gemm_phase<s5::EpiY, s5::OrderY, true, true>(F.lds, g, S, E); }
#endif
            moe_cvt_window(F, args, l, 1);
#ifndef NO_HG
            REPB(30) for (int u = blockIdx.x; u < 1024; u += F.G) hg::unit_c(u, PROJ, lbl, HGS, ain(args, 18) + l * 128, YCAT, F.lds);
#endif
#ifndef NO_ATTN
            for (int u2 = blockIdx.x * 2, nu2_ = (REP_PHASE == 32) ? opq_s(1024) : 512; u2 < nu2_; u2 += F.G * 2) for (int s = 0; s < 2; ++s) { const int u = (u2 >> 1) & 255, h = u & 7, pi = u >> 3;
#if REP_PHASE == 32
                if (u2 < 512) at8::attn_unit<PVAR>(h, s ? pi : 63 - pi, Qb, Kb, Vb, rope, YCAT, D, 512, (LAS char*)F.lds); else
#endif
                at8::attn_unit<0>(h, s ? pi : 63 - pi, Qb, Kb, Vb, rope, YCAT, D, 512, (LAS char*)F.lds); }
#endif
        }
        SEAM(pb + 3);
        if (IN(pb + 4)) REPB(4) {
#ifndef NO_S5
            pg8::Gemm g{YG, (const bf16*)(wsl(ws) + WS_WGLU + l * WGLU_L), M, 512, 512, 512}; pg8::StaticOrder S; S.init(M, 512, F.G, (int)blockIdx.x); s5::EpiGlu E{YG, ain(args, 12) + l * 512, YCAT};
            pg8::gemm_phase<s5::EpiGlu, pg8::StaticOrder, true, true>(F.lds, g, S, E);
#endif
            moe_cvt_window(F, args, l, 2);
        }
        SEAM(pb + 4);


        if (IN(pb + 5)) REPB(5) {
#ifndef NO_P5
            pg8::Gemm g{YCAT, (const bf16*)(wsl(ws) + WS_WOUT + l * WOUT_L), M, D, D, D}; pg8::StaticOrder S; S.init(M, D, F.G, (int)blockIdx.x); EpiRes E{l == 0 ? (const void*)ain(args, 0) : (const void*)R1, PRE, l == 0};
            pg8::gemm_phase<EpiRes, pg8::StaticOrder, true, true>(F.lds, g, S, E);
#endif
        }
        SEAM(pb + 5);
        if (IN(pb + 6)) REPB(6) {
#ifndef NO_P6
            if (l == 0) ln_pass<false>(F, PRE, ain(args, 19), ain(args, 20), R0, nullptr, wsl(ws) + WS_X8, (float*)(wsl(ws) + WS_SMALL + SM_XS), nullptr, nullptr, nullptr);
            else ln_pass<true>(F, PRE, ain(args, 19) + D, ain(args, 20) + D, R0, nullptr, wsl(ws) + WS_X8, (float*)(wsl(ws) + WS_SMALL + SM_XS), ain(args, 26), TIDX, TW);
#endif
        }
        SEAM(pb + 6);
        if (IN(pb + 7)) REPB(7) {
#ifndef NO_P7
            if (l == 0) { pg8::Gemm g{(const bf16*)(wsl(ws) + WS_X8), (const bf16*)(wsl(ws) + WS_FFNGU), M, 2 * DFF, D / 2, D / 2}; pg8::StaticOrder S; S.init(M, 2 * DFF, F.G, (int)blockIdx.x);
                EpiSwiglu E{(bf16*)(wsl(ws) + WS_H), DFF, WI8_S, (const float*)(wsl(ws) + WS_SMALL + SM_XS)};
                pg8::gemm_phase_i8<EpiSwiglu, pg8::StaticOrder, true, true>(F.lds, g, S, E); }
            else moe_dispatch(F, TIDX, wsl(ws) + WS_X8, (const float*)(wsl(ws) + WS_SMALL + SM_XS), wsl(ws) + WS_XG8, (float*)(wsl(ws) + WS_SMALL + SM_XGS), POS, CNT, F.lds);
#endif
        }
        SEAM(pb + 7);
        if (IN(pb + 8)) REPB(8) {
#ifndef NO_P8
            if (l == 0) { pg8::Gemm g{(const bf16*)(wsl(ws) + WS_H), (const bf16*)(wsl(ws) + WS_FFND), M, D, DFF, DFF}; pg8::StaticOrder S; S.init(M, D, F.G, (int)blockIdx.x); EpiRes E{R0, PRE, 0};
                pg8::gemm_phase<EpiRes, pg8::StaticOrder, true, true>(F.lds, g, S, E); }
            else { pg8::Gemm g{(const bf16*)(wsl(ws) + WS_XG8), (const bf16*)(wsl(ws) + WS_MOEGU), 34816, 2 * DFE, D / 2, D / 2}; OrderMoE S; S.init(CNT, 56, F.G, (int)blockIdx.x);
                EpiSwiglu8 E{wsl(ws) + WS_HM, DFE, WI8_S, H8_SCALE, (const float*)(wsl(ws) + WS_SMALL + SM_XGS)};
                pg8::gemm_phase_i8<EpiSwiglu8, OrderMoE, true, true>(F.lds, g, S, E); }
#endif
        }
        SEAM(pb + 8);
        if (IN(pb + 9)) REPB(9) {
#ifndef NO_P9
            if (l == 0) ln_pass<false>(F, PRE, ain(args, 21), ain(args, 22), R1, nullptr, wsl(ws) + WS_X8, (float*)(wsl(ws) + WS_SMALL + SM_XS), nullptr, nullptr, nullptr);
            else { pg8::Gemm g{(const bf16*)(wsl(ws) + WS_HM), (const bf16*)(wsl(ws) + WS_MOED), 34816, D, DFE / 2, DFE / 2}; OrderMoE S; S.init(CNT, 8, F.G, (int)blockIdx.x);
                if (F.G == 256 && S.ntile > TAIL_RT0) S.ntile = TAIL_RT0;
                EpiStoreBf E{(bf16*)(wsl(ws) + WS_OS), D, 1.f / (H8_SCALE * WD8_SCALE)};
                pg8::gemm_phase8<EpiStoreBf, OrderMoE, true, true>(F.lds, g, S, E);
                if (F.G == 256) { const int ks = (int)blockIdx.x & 3; OrderTail T; T.init(CNT, (int)blockIdx.x);
                    pg8::Gemm g2{(const bf16*)(wsl(ws) + WS_HM) + ks * (DFE / 8), (const bf16*)(wsl(ws) + WS_MOED) + ks * (DFE / 8), 34816, D, DFE / 8, DFE / 2, DFE / 2};
                    EpiTail E2{(float*)(wsl(ws) + WS_H) + (size_t)ks * TAIL_ROWS * D};
                    pg8::gemm_phase8<EpiTail, OrderTail, true, true>(F.lds, g2, T, E2); } }
#endif
        }
        SEAM(pb + 9);
        if (IN(pb + 10)) REPB(10) {
#ifndef NO_P10
            if (l == 1) ln_moe_pass(F, R0, (const bf16*)(wsl(ws) + WS_OS), POS, TW, ain(args, 21) + D, ain(args, 22) + D, args.out, F.G == 256 ? (const float*)(wsl(ws) + WS_H) : nullptr, 1.f / (H8_SCALE * WD8_SCALE));
#endif
        }
        if (l == 1) SEAM(pb + 10);
    }
#undef IN
#undef SEAM
#undef XB
#undef PROJ
#undef U2
#undef Qb
#undef Kb
#undef Vb
#undef YCAT
#undef YG
#undef Ebuf
#undef HGU
#undef HGS
#undef HGG
#undef lbl
#undef rstdq
#undef rstdkv
#undef rope
#undef PRE
#undef R0
#undef R1
#undef TIDX
#undef TW
#undef POS
#undef CNT
}
}
#ifndef MK_LAUNCHES
#define MK_LAUNCHES 1
#endif
extern "C" void kernel_launch(void* const* d_in, const int* in_sizes, int n_in, void* d_out, int out_size, void* d_ws, size_t ws_size, hipStream_t stream) {
    (void)in_sizes; (void)out_size;
    using namespace mk;
    static int grid = 0;
    if (!grid) {
        int dev = 0, cus = 0; (void)hipGetDevice(&dev); (void)hipDeviceGetAttribute(&cus, hipDeviceAttributeMultiprocessorCount, dev);
        if (hipFuncSetAttribute((const void*)mk_fwd, hipFuncAttributeMaxDynamicSharedMemorySize, LDS_BYTES) != hipSuccess) fprintf(stderr, "kernel_launch: hipFuncSetAttribute(%d B LDS) failed\n", LDS_BYTES);
        int per_cu = 0; (void)hipOccupancyMaxActiveBlocksPerMultiprocessor(&per_cu, (const void*)mk_fwd, NWAVES * 64, LDS_BYTES); (void)hipGetLastError();
        if (per_cu < 1) fprintf(stderr, "kernel_launch: occupancy query reports %d blocks per CU\n", per_cu);
        grid = cus > 0 ? cus : 256;
    }
    if (n_in != 30 || ws_size < WS_END) { fprintf(stderr, "kernel_launch: need 30 inputs and %zu bytes of workspace (got %d, %zu)\n", (size_t)WS_END, n_in, ws_size); return; }
    unsigned char* ws = (unsigned char*)d_ws;
    (void)hipMemsetAsync(ws + WS_CTL, 0, CTL_ZERO_BYTES, stream);
    Args a{}; for (int i = 0; i < 30; ++i) a.in[i] = (const float*)d_in[i]; a.out = (float*)d_out; a.ws = ws; a.prep_mask = 255;
    constexpr int NPH = 2 + 2 * NPH_L;
    if (MK_LAUNCHES == 1) { a.ph_lo = 0; a.ph_hi = NPH; a.li = 0; hipLaunchKernelGGL(mk_fwd, dim3(grid), dim3(NWAVES * 64), LDS_BYTES, stream, a); }
    else for (int p = 0; p < NPH; ++p) { a.ph_lo = p; a.ph_hi = p + 1; a.li = 0; hipLaunchKernelGGL(mk_fwd, dim3(grid), dim3(NWAVES * 64), LDS_BYTES, stream, a); }
}
```
